# Optimizing an MI355X kernel written in HIP

```python
import math
import jax, jax.numpy as jnp
from jax import lax
import numpy as np

D_MODEL = 1024
BATCH = 2
SEQ = 8192
DEPTH = 1

ATTN_HEADS = 16
ATTN_KV_HEADS = 4
HEAD_DIM = 64
ATTN_WIDTH = ATTN_HEADS * HEAD_DIM
KV_WIDTH = ATTN_KV_HEADS * HEAD_DIM
WINDOW = 128
BLOCK = 128
REL_BUCKETS = 32
REL_MAX_DIST = 128
SSM_EXPAND = 2
SSM_WIDTH = SSM_EXPAND * D_MODEL
SSM_HEAD_DIM = 64
SSM_HEADS = SSM_WIDTH // SSM_HEAD_DIM
SSM_GROUPS = 4
SSM_HEADS_PER_GROUP = SSM_HEADS // SSM_GROUPS
SSM_STATE = 128
CONV_WIDTH = 4
CHUNK = 128
XBC_WIDTH = SSM_WIDTH + 2 * SSM_GROUPS * SSM_STATE
DT_MIN = 0.001
DT_MAX = 0.1
N_BRANCH = 2
IN_WIDTH = ATTN_WIDTH + 2 * KV_WIDTH + ATTN_WIDTH + SSM_WIDTH + XBC_WIDTH + SSM_HEADS + N_BRANCH * D_MODEL
EPS = 1e-6

kernel_name = "hybrid_swa_sink_ssd_gated_merge"


def rms_norm(x, w, eps=EPS):
    xf = x.astype(jnp.float32)
    xf = xf * lax.rsqrt(jnp.mean(xf * xf, axis=-1, keepdims=True) + eps)
    return (xf * w.astype(jnp.float32)).astype(x.dtype)


def t5_causal_bucket(dist):
    n = jnp.maximum(dist, 0)
    max_exact = REL_BUCKETS // 2
    nf = jnp.maximum(n, 1).astype(jnp.float32)
    large = max_exact + (jnp.log(nf / max_exact) / math.log(REL_MAX_DIST / max_exact)
                         * (REL_BUCKETS - max_exact)).astype(jnp.int32)
    large = jnp.minimum(large, REL_BUCKETS - 1)
    return jnp.where(n < max_exact, n, large)


def sliding_window_attention(q, k, v, q_norm_w, k_norm_w, rel_bias, sinks):
    b, s = q.shape[0], q.shape[1]
    nb = s // BLOCK
    grp = ATTN_HEADS // ATTN_KV_HEADS
    q = rms_norm(q, q_norm_w)
    k = rms_norm(k, k_norm_w)
    qb = q.reshape(b, nb, BLOCK, ATTN_KV_HEADS, grp, HEAD_DIM)

    def banded(t):
        tb = t.reshape(b, nb, BLOCK, ATTN_KV_HEADS, HEAD_DIM)
        prev = jnp.concatenate([jnp.zeros_like(tb[:, :1]), tb[:, :-1]], axis=1)
        return jnp.concatenate([prev, tb], axis=2)

    kb, vb = banded(k), banded(v)
    scores = jnp.einsum("bnqhgd,bnkhd->bnhgqk", qb, kb).astype(jnp.float32) * (HEAD_DIM ** -0.5)

    qi = jnp.arange(BLOCK)[:, None]
    kj = jnp.arange(2 * BLOCK)[None, :]
    dist = qi + BLOCK - kj
    key_pos = jnp.arange(nb)[:, None, None] * BLOCK - BLOCK + kj[None]
    mask = (dist >= 0) & (dist < WINDOW) & (key_pos >= 0)
    bias = rel_bias.astype(jnp.float32)[t5_causal_bucket(dist)]
    bias = bias.reshape(BLOCK, 2 * BLOCK, ATTN_KV_HEADS, grp).transpose(2, 3, 0, 1)
    scores = jnp.where(mask[None, :, None, None], scores + bias[None, None], -jnp.inf)

    sink = sinks.astype(jnp.float32).reshape(ATTN_KV_HEADS, grp)[None, None, :, :, None, None]
    m = jnp.maximum(scores.max(axis=-1, keepdims=True), sink)
    p = jnp.exp(scores - m)
    probs = p / (p.sum(axis=-1, keepdims=True) + jnp.exp(sink - m))
    out = jnp.einsum("bnhgqk,bnkhd->bnqhgd", probs.astype(v.dtype), vb)
    return out.reshape(b, s, ATTN_WIDTH)


def causal_depthwise_conv(x, w, bias):
    out = lax.conv_general_dilated(
        x, w[:, None, :].astype(x.dtype), window_strides=(1,), padding=[(CONV_WIDTH - 1, 0)],
        dimension_numbers=("NWC", "WIO", "NWC"), feature_group_count=x.shape[-1])
    return out + bias


def ssd_chunked(xs, dt, a, bm, cm):
    b, s = xs.shape[0], xs.shape[1]
    nc = s // CHUNK
    G, R, P, N = SSM_GROUPS, SSM_HEADS_PER_GROUP, SSM_HEAD_DIM, SSM_STATE
    xs = xs.reshape(b, nc, CHUNK, G, R, P).astype(jnp.float32)
    dt = dt.reshape(b, nc, CHUNK, G, R)
    bm = bm.reshape(b, nc, CHUNK, G, N).astype(jnp.float32)
    cm = cm.reshape(b, nc, CHUNK, G, N).astype(jnp.float32)
    a_cum = jnp.cumsum(dt * a, axis=2)
    xdt = xs * dt[..., None]
    causal = jnp.tril(jnp.ones((CHUNK, CHUNK), dtype=bool))[:, :, None, None]
    seg = a_cum[:, :, :, None] - a_cum[:, :, None, :]
    decay = jnp.exp(jnp.where(causal, seg, -jnp.inf))
    cb = jnp.einsum("bclgn,bcsgn->bclsg", cm, bm)
    y_diag = jnp.einsum("bclsg,bclsgr,bcsgrp->bclgrp", cb, decay, xdt)
    decay_to_end = jnp.exp(a_cum[:, :, -1:] - a_cum)
    states = jnp.einsum("bclgn,bclgr,bclgrp->bcgrpn", bm, decay_to_end, xdt)
    chunk_decay = jnp.exp(a_cum[:, :, -1])

    def step(h, inp):
        st, dec = inp
        return h * dec[..., None, None] + st, h

    h0 = jnp.zeros((b, G, R, P, N), jnp.float32)
    _, h_prev = lax.scan(step, h0, (jnp.moveaxis(states, 1, 0), jnp.moveaxis(chunk_decay, 1, 0)))
    h_prev = jnp.moveaxis(h_prev, 0, 1)
    y_off = jnp.einsum("bclgn,bcgrpn,bclgr->bclgrp", cm, h_prev, jnp.exp(a_cum))
    return (y_diag + y_off).reshape(b, s, G, R, P)


def hybrid_layer(x, c, w_ada, b_ada, norm_w, w_in, q_norm_w, k_norm_w, rel_bias, sinks,
                 conv_w, conv_b, dt_bias, a_log, d_skip, ssm_norm_w,
                 w_attn_proj, w_ssm_proj, w_out):
    b, s, _ = x.shape
    G, R, P, N = SSM_GROUPS, SSM_HEADS_PER_GROUP, SSM_HEAD_DIM, SSM_STATE
    mod = jax.nn.silu(c) @ w_ada + b_ada
    shift, scale, gate = jnp.split(mod, 3, axis=-1)
    h = rms_norm(x, norm_w) * (1 + scale[:, None]) + shift[:, None]
    proj = h @ w_in
    widths = [ATTN_WIDTH, KV_WIDTH, KV_WIDTH, ATTN_WIDTH, SSM_WIDTH, XBC_WIDTH, SSM_HEADS, D_MODEL, D_MODEL]
    q, k, v, z_a, z_m, xbc, dt_raw, g_a, g_b = jnp.split(proj, list(np.cumsum(widths)[:-1]), axis=-1)

    y_a = sliding_window_attention(q.reshape(b, s, ATTN_HEADS, HEAD_DIM),
                                   k.reshape(b, s, ATTN_KV_HEADS, HEAD_DIM),
                                   v.reshape(b, s, ATTN_KV_HEADS, HEAD_DIM),
                                   q_norm_w, k_norm_w, rel_bias, sinks)
    y_a = (y_a * jax.nn.silu(z_a)) @ w_attn_proj

    xbc = jax.nn.silu(causal_depthwise_conv(xbc, conv_w, conv_b))
    xs, bm, cm = jnp.split(xbc, [SSM_WIDTH, SSM_WIDTH + G * N], axis=-1)
    xs = xs.reshape(b, s, G, R, P)
    dt = jax.nn.softplus((dt_raw + dt_bias).astype(jnp.float32)).reshape(b, s, G, R)
    a = -jnp.exp(a_log.astype(jnp.float32)).reshape(G, R)
    y = ssd_chunked(xs, dt, a, bm.reshape(b, s, G, N), cm.reshape(b, s, G, N))
    y = y + d_skip.astype(jnp.float32).reshape(G, R)[:, :, None] * xs.astype(jnp.float32)
    y = y.reshape(b, s, SSM_WIDTH).astype(x.dtype) * jax.nn.silu(z_m)
    y = rms_norm(y.reshape(b, s, G, SSM_WIDTH // G), ssm_norm_w.reshape(G, SSM_WIDTH // G))
    y_b = y.reshape(b, s, SSM_WIDTH) @ w_ssm_proj

    merged = jax.nn.sigmoid(g_a) * y_a + jax.nn.sigmoid(g_b) * y_b
    return x + gate[:, None] * (merged @ w_out)


def setup_inputs(seed: int = 0) -> dict:
    key = jax.random.key(seed)
    ks = jax.random.split(key, 20)
    nrm = jax.random.normal
    L, D = DEPTH, D_MODEL
    dt0 = jnp.exp(jax.random.uniform(ks[12], (L, SSM_HEADS)) * (math.log(DT_MAX) - math.log(DT_MIN)) + math.log(DT_MIN))
    return {
        "x": nrm(ks[0], (BATCH, SEQ, D), jnp.float32),
        "c": nrm(ks[1], (BATCH, D), jnp.float32),
        "w_ada": nrm(ks[2], (L, D, 3 * D)) * (0.5 * D ** -0.5),
        "b_ada": 0.01 * nrm(ks[3], (L, 3 * D)),
        "norm_w": 1 + 0.02 * nrm(ks[4], (L, D)),
        "w_in": nrm(ks[5], (L, D, IN_WIDTH)) * D ** -0.5,
        "q_norm_w": 1 + 0.02 * nrm(ks[6], (L, HEAD_DIM)),
        "k_norm_w": 1 + 0.02 * nrm(ks[7], (L, HEAD_DIM)),
        "rel_bias": 0.5 * nrm(ks[8], (REL_BUCKETS, ATTN_HEADS)),
        "sinks": 0.5 * nrm(ks[9], (L, ATTN_HEADS)),
        "conv_w": nrm(ks[10], (L, CONV_WIDTH, XBC_WIDTH)) * CONV_WIDTH ** -0.5,
        "conv_b": 0.01 * nrm(ks[11], (L, XBC_WIDTH)),
        "dt_bias": dt0 + jnp.log(-jnp.expm1(-dt0)),
        "a_log": jnp.log(jax.random.uniform(ks[13], (L, SSM_HEADS), minval=1.0, maxval=16.0)),
        "d_skip": 1 + 0.1 * nrm(ks[14], (L, SSM_HEADS)),
        "ssm_norm_w": 1 + 0.02 * nrm(ks[15], (L, SSM_WIDTH)),
        "w_attn_proj": nrm(ks[16], (L, ATTN_WIDTH, D)) * ATTN_WIDTH ** -0.5,
        "w_ssm_proj": nrm(ks[17], (L, SSM_WIDTH, D)) * SSM_WIDTH ** -0.5,
        "w_out": nrm(ks[18], (L, D, D)) * D ** -0.5,
    }


def reference(x, c, w_ada, b_ada, norm_w, w_in, q_norm_w, k_norm_w, rel_bias, sinks,
              conv_w, conv_b, dt_bias, a_log, d_skip, ssm_norm_w,
              w_attn_proj, w_ssm_proj, w_out):
    for i in range(DEPTH):
        x = hybrid_layer(x, c, w_ada[i], b_ada[i], norm_w[i], w_in[i], q_norm_w[i], k_norm_w[i],
                         rel_bias, sinks[i], conv_w[i], conv_b[i], dt_bias[i], a_log[i], d_skip[i],
                         ssm_norm_w[i], w_attn_proj[i], w_ssm_proj[i], w_out[i])
    return x
```

```cpp
#include <hip/hip_runtime.h>
#include <cstdio>
#include <cstdint>
#include <cmath>
namespace pg8 {
#define PG8_LAS __attribute__((address_space(3)))
typedef unsigned short bf16_t;
typedef short bf16x8 __attribute__((ext_vector_type(8)));
typedef float f32x4 __attribute__((ext_vector_type(4)));
typedef unsigned u32x4 __attribute__((ext_vector_type(4)));
constexpr int BM = 256, BK = 64, HALF = 128, HTB = HALF * BK * 2  , STAGE_BYTES = 8 * HTB, NXCD = 8, WGM = 8;

__host__ __device__ __forceinline__ int lds_byte(int r, int c) { const int st = (r >> 4) * 2 + (c >> 5), rr = r & 15, cc = c & 31, ob = rr * 64 + cc * 2; return st * 1024 + (ob ^ (((ob >> 9) & 1) << 5)); }
__host__ __device__ __forceinline__ void stage_rc(int b, int& R, int& C) { const int st = b / 1024, sb = b % 1024, swz = sb ^ (((sb >> 9) & 1) << 5); R = (st >> 1) * 16 + swz / 64; C = (st & 1) * 32 + (swz % 64) / 2; }
__host__ __device__ __forceinline__ int perm32(int rho) { const int n = rho >> 4, i = rho & 15; return 8 * (i >> 2) + 4 * n + (i & 3); }

struct Unit { int pm, pn; };
struct Gemm { const bf16_t* A; const bf16_t* Bt; int M, N, K; };

struct StaticOrder {
    int nM, nN, nwg, G, c;
    __host__ __device__ void init(int M, int N, int G_, int c_) { nM = M / BM; nN = N / BM; nwg = nM * nN; G = G_; c = c_; }
    __host__ __device__ bool next(int i, Unit& u) const {
        const long L = (long)i * G + c; if (L >= nwg) return false;
        int wgid = (int)L; { const int q = nwg / NXCD, r = nwg % NXCD, xcd = wgid % NXCD, off = wgid / NXCD; wgid = (xcd < r ? xcd * (q + 1) : r * (q + 1) + (xcd - r) * q) + off; }
        const int nig = WGM * nN, gid = wgid / nig, fm = gid * WGM, gsz = (nM - fm) < WGM ? (nM - fm) : WGM;
        u.pm = fm + ((wgid % nig) % gsz); u.pn = (wgid % nig) / gsz; return true;
    }
    __device__ __forceinline__ void a_ready(const Unit&) const {}
    __device__ __forceinline__ void done(const Unit&) const {}
};

__device__ __forceinline__ unsigned cvt_pk_bf16(float lo, float hi) { unsigned r; asm volatile("v_cvt_pk_bf16_f32 %0, %1, %2" : "=v"(r) : "v"(lo), "v"(hi)); return r; }
__device__ __forceinline__ float sigm(float v) { return __builtin_amdgcn_rcpf(1.f + __builtin_amdgcn_exp2f(-1.4426950408889634f * v)); }
__device__ __forceinline__ float bflo(unsigned w) { return __uint_as_float(w << 16); }
__device__ __forceinline__ float bfhi(unsigned w) { return __uint_as_float(w & 0xffff0000u); }

struct EpiInProj {
    static constexpr bool PERM = true, AFTER_DRAIN = false;
    bf16_t *Q, *Kb, *Vb, *ZA, *ZM, *XBC, *GA, *GB; float* DT; const float* dt_bias; int tile_off;
    __device__ __forceinline__ void operator()(const f32x4 (&acc)[2][2][4][2], const Unit& u, int wr, int wc, int fr, int fq) const {
        const int pn = u.pn + tile_off;
        const int row0 = u.pm * BM + wr * 64 + fr;
        if (pn == 30) {
            if (wc == 0) {
                const int c = 8 * fq;
                const f32x4 b0 = *(const f32x4*)(dt_bias + c), b1 = *(const f32x4*)(dt_bias + c + 4);
#pragma unroll
                for (int ai = 0; ai < 2; ++ai)
#pragma unroll
                    for (int m = 0; m < 4; ++m) {
                        float* rp = DT + (size_t)(row0 + ai * HALF + m * 16) * 32 + c;
                        f32x4 v0 = acc[ai][0][m][0] + b0, v1 = acc[ai][0][m][1] + b1;
#pragma unroll
                        for (int j = 0; j < 4; ++j) { v0[j] = v0[j] > 15.f ? v0[j] : log1pf(__expf(v0[j])); v1[j] = v1[j] > 15.f ? v1[j] : log1pf(__expf(v1[j])); }
                        *(f32x4*)rp = v0; *(f32x4*)(rp + 4) = v1;
                    }
            }
            return;
        }
        bf16_t* base; int ldc, c0, act;
        if (pn < 4) { base = Q; ldc = 1024; c0 = pn * 256; act = 0; }
        else if (pn == 4) { base = Kb; ldc = 256; c0 = 0; act = 0; }
        else if (pn == 5) { base = Vb; ldc = 256; c0 = 0; act = 0; }
        else if (pn < 10) { base = ZA; ldc = 1024; c0 = (pn - 6) * 256; act = 1; }
        else if (pn < 18) { base = ZM; ldc = 2048; c0 = (pn - 10) * 256; act = 1; }
        else if (pn < 30) { base = XBC; ldc = 3072; c0 = (pn - 18) * 256; act = 0; }
        else if (pn < 35) { base = GA; ldc = 1024; c0 = (pn - 31) * 256; act = 2; }
        else { base = GB; ldc = 1024; c0 = (pn - 35) * 256; act = 2; }
        const int col0 = c0 + wc * 32 + 8 * fq;
#pragma unroll
        for (int ai = 0; ai < 2; ++ai)
#pragma unroll
            for (int m = 0; m < 4; ++m) { bf16_t* rowp = base + (size_t)(row0 + ai * HALF + m * 16) * ldc + col0;
#pragma unroll
                for (int bj = 0; bj < 2; ++bj) { f32x4 v0 = acc[ai][bj][m][0], v1 = acc[ai][bj][m][1];
                    if (act == 1) {
#pragma unroll
                        for (int j = 0; j < 4; ++j) { v0[j] = v0[j] * sigm(v0[j]); v1[j] = v1[j] * sigm(v1[j]); } }
                    else if (act == 2) {
#pragma unroll
                        for (int j = 0; j < 4; ++j) { v0[j] = sigm(v0[j]); v1[j] = sigm(v1[j]); } }
                    u32x4 w; w.x = cvt_pk_bf16(v0[0], v0[1]); w.y = cvt_pk_bf16(v0[2], v0[3]); w.z = cvt_pk_bf16(v1[0], v1[1]); w.w = cvt_pk_bf16(v1[2], v1[3]);
                    *(u32x4*)(rowp + bj * HALF) = w; } }
    }
};

template <int MODE> struct EpiGate {
    static constexpr bool PERM = true, AFTER_DRAIN = false;
    const bf16_t* G; bf16_t* O;
    __device__ __forceinline__ void operator()(const f32x4 (&acc)[2][2][4][2], const Unit& u, int wr, int wc, int fr, int fq) const {
        const int row0 = u.pm * BM + wr * 64 + fr, col0 = u.pn * BM + wc * 32 + 8 * fq;
#pragma unroll
        for (int ai = 0; ai < 2; ++ai)
#pragma unroll
            for (int m = 0; m < 4; ++m) { const size_t off = (size_t)(row0 + ai * HALF + m * 16) * 1024 + col0;
#pragma unroll
                for (int bj = 0; bj < 2; ++bj) { const f32x4 v0 = acc[ai][bj][m][0], v1 = acc[ai][bj][m][1];
                    const u32x4 g = *(const u32x4*)(G + off + bj * HALF);
                    float r[8];
                    r[0] = bflo(g.x) * v0[0]; r[1] = bfhi(g.x) * v0[1]; r[2] = bflo(g.y) * v0[2]; r[3] = bfhi(g.y) * v0[3];
                    r[4] = bflo(g.z) * v1[0]; r[5] = bfhi(g.z) * v1[1]; r[6] = bflo(g.w) * v1[2]; r[7] = bfhi(g.w) * v1[3];
                    if (MODE == 1) { const u32x4 o = *(const u32x4*)(O + off + bj * HALF);
                        r[0] += bflo(o.x); r[1] += bfhi(o.x); r[2] += bflo(o.y); r[3] += bfhi(o.y); r[4] += bflo(o.z); r[5] += bfhi(o.z); r[6] += bflo(o.w); r[7] += bfhi(o.w); }
                    u32x4 w; w.x = cvt_pk_bf16(r[0], r[1]); w.y = cvt_pk_bf16(r[2], r[3]); w.z = cvt_pk_bf16(r[4], r[5]); w.w = cvt_pk_bf16(r[6], r[7]);
                    *(u32x4*)(O + off + bj * HALF) = w; } }
    }
};

struct EpiOut {
    static constexpr bool PERM = false, AFTER_DRAIN = false;
    const float* x; const float* gate; float* out;
    __device__ __forceinline__ void operator()(const f32x4 (&acc)[2][2][4][2], const Unit& u, int wr, int wc, int fr, int fq) const {
        const int row0 = u.pm * BM + wr * 64 + fr, col0 = u.pn * BM + wc * 32 + 4 * fq;
        const float* gb = gate + (size_t)((u.pm * BM) >> 13) * 3072;
#pragma unroll
        for (int bj = 0; bj < 2; ++bj)
#pragma unroll
            for (int n = 0; n < 2; ++n) { const int c = col0 + bj * HALF + n * 16; const f32x4 gv = *(const f32x4*)(gb + c);
#pragma unroll
                for (int ai = 0; ai < 2; ++ai)
#pragma unroll
                    for (int m = 0; m < 4; ++m) { const size_t off = (size_t)(row0 + ai * HALF + m * 16) * 1024 + c;
                        const f32x4 xv = *(const f32x4*)(x + off); *(f32x4*)(out + off) = xv + gv * acc[ai][bj][m][n]; } }
    }
};

template <class Epi, class Sched, bool ALIGN_EPI = false, bool SP2 = false>
__device__ __forceinline__ void gemm_phase(PG8_LAS unsigned char* lds, const Gemm g, const Sched& S, const Epi& E) {
    const int tid = threadIdx.x, wid = __builtin_amdgcn_readfirstlane(tid >> 6), lane = tid & 63, wr = wid >> 2, wc = wid & 3, fr = lane & 15, fq = lane >> 4;
    const int K = g.K, nt = K / BK;
    unsigned voffA[2], voffB[2];
#pragma unroll
    for (int i = 0; i < 2; ++i) { int R, C; stage_rc(tid * 16 + i * 8192, R, C); const int Rb = Epi::PERM ? ((R & ~31) + perm32(R & 31)) : R;
        voffA[i] = (unsigned)(R * K + C) * 2u; voffB[i] = (unsigned)(Rb * K + C) * 2u; }
    const size_t kstep = (size_t)(BK * 2);
    const size_t hstep = (size_t)HALF * K * 2;
    const size_t tstep = 2 * hstep;
    const unsigned ldsw = (unsigned)wid * 1024u;
    const int aoff = lds_byte(wr * 64 + fr, fq * 8), boff = lds_byte(wc * 32 + fr, fq * 8);
#define PG8_SA(b, h) (((b) * 2 + (h)) * HTB)
#define PG8_SB(b, h) ((4 + (b) * 2 + (h)) * HTB)
#define PG8_STAGE(bufoff, gbase, voff) do { _Pragma("unroll") for (int _i = 0; _i < 2; ++_i) \
        __builtin_amdgcn_global_load_lds((const unsigned*)((const char*)(gbase) + (voff)[_i]), (PG8_LAS unsigned*)(lds + (bufoff) + ldsw + _i * 8192), 16, 0, 0); } while (0)
#define PG8_LDA(dst, b, h) do { _Pragma("unroll") for (int m = 0; m < 4; ++m) _Pragma("unroll") for (int k = 0; k < 2; ++k) dst[m][k] = *(const PG8_LAS bf16x8*)(lds + PG8_SA(b, h) + aoff + m * 2048 + k * 1024); } while (0)
#define PG8_LDB(dst, b, h) do { _Pragma("unroll") for (int n = 0; n < 2; ++n) _Pragma("unroll") for (int k = 0; k < 2; ++k) dst[n][k] = *(const PG8_LAS bf16x8*)(lds + PG8_SB(b, h) + boff + n * 2048 + k * 1024); } while (0)
#define PG8_MMA(ai, bj, At, Bt) do { __builtin_amdgcn_s_setprio(1); _Pragma("unroll") for (int m = 0; m < 4; ++m) _Pragma("unroll") for (int n = 0; n < 2; ++n) _Pragma("unroll") for (int k = 0; k < 2; ++k) \
        acc[ai][bj][m][n] = __builtin_amdgcn_mfma_f32_16x16x32_bf16(Bt[n][k], At[m][k], acc[ai][bj][m][n], 0, 0, 0); __builtin_amdgcn_s_setprio(0); } while (0)
#define PG8_WAIT_V(n) asm volatile("s_waitcnt vmcnt(" #n ")" ::: "memory")
#define PG8_WAIT_L(n) asm volatile("s_waitcnt lgkmcnt(" #n ")" ::: "memory")
#define PG8_BAR __builtin_amdgcn_s_barrier()
#define PG8_SCHED __builtin_amdgcn_sched_barrier(0)
    Unit cur, nxt; int ui = 0;
    if (!S.next(0, cur)) return;
    f32x4 acc[2][2][4][2];
#pragma unroll
    for (int a = 0; a < 2; ++a)
#pragma unroll
        for (int b = 0; b < 2; ++b)
#pragma unroll
            for (int m = 0; m < 4; ++m)
#pragma unroll
                for (int n = 0; n < 2; ++n) acc[a][b][m][n] = (f32x4){0.f, 0.f, 0.f, 0.f};
    bf16x8 At[4][2], B0[2][2], B1[2][2];
    const char* cA = (const char*)g.A + (size_t)cur.pm * tstep; const char* cB = (const char*)g.Bt + (size_t)cur.pn * tstep;
    S.a_ready(cur);
    if constexpr (SP2) {
        PG8_STAGE(PG8_SB(0, 0), cB, voffB); PG8_STAGE(PG8_SB(0, 1), cB + hstep, voffB); PG8_STAGE(PG8_SA(0, 0), cA, voffA); PG8_STAGE(PG8_SA(0, 1), cA + hstep, voffA);
        if (wr == 1) PG8_BAR;
        PG8_WAIT_V(2); PG8_BAR;
        PG8_STAGE(PG8_SB(1, 0), cB + kstep, voffB); PG8_STAGE(PG8_SA(1, 0), cA + kstep, voffA); PG8_STAGE(PG8_SB(1, 1), cB + hstep + kstep, voffB);
        PG8_WAIT_V(6); PG8_BAR;
    } else {
        PG8_STAGE(PG8_SB(0, 0), cB, voffB); PG8_STAGE(PG8_SA(0, 0), cA, voffA); PG8_STAGE(PG8_SB(0, 1), cB + hstep, voffB); PG8_STAGE(PG8_SA(0, 1), cA + hstep, voffA);
        if (wr == 1) PG8_BAR;
        PG8_WAIT_V(4); PG8_BAR;
        PG8_STAGE(PG8_SB(1, 0), cB + kstep, voffB); PG8_STAGE(PG8_SA(1, 0), cA + kstep, voffA); PG8_STAGE(PG8_SB(1, 1), cB + hstep + kstep, voffB);
        PG8_WAIT_V(6); PG8_BAR;
    }
    for (;;) {
        const bool has_next = S.next(ui + 1, nxt);
        const char* nA = has_next ? (const char*)g.A + (size_t)nxt.pm * tstep : cA; const char* nB = has_next ? (const char*)g.Bt + (size_t)nxt.pn * tstep : cB;
        for (int t = 0; t < nt; t += 2) {
            const bool last = (t == nt - 2);
            const char* a1 = cA + (size_t)(t + 1) * kstep;
            const char* a2 = last ? nA : cA + (size_t)(t + 2) * kstep; const char* b2 = last ? nB : cB + (size_t)(t + 2) * kstep;
            const char* a3 = a2 + kstep; const char* b3 = b2 + kstep;
            if (last && has_next) S.a_ready(nxt);
            if constexpr (SP2) {
            PG8_LDB(B0, 0, 0); PG8_LDB(B1, 0, 1); PG8_SCHED; PG8_LDA(At, 0, 0); PG8_STAGE(PG8_SA(1, 1), a1 + hstep, voffA);
            PG8_WAIT_V(8); PG8_WAIT_L(0); PG8_BAR; PG8_MMA(0, 0, At, B0); PG8_MMA(0, 1, At, B1); PG8_BAR; PG8_SCHED;
            PG8_LDA(At, 0, 1); PG8_STAGE(PG8_SB(0, 0), b2, voffB); PG8_STAGE(PG8_SB(0, 1), b2 + hstep, voffB); PG8_STAGE(PG8_SA(0, 0), a2, voffA);
            PG8_WAIT_V(8); PG8_WAIT_L(0); PG8_BAR; PG8_MMA(1, 0, At, B0); PG8_MMA(1, 1, At, B1); PG8_BAR; PG8_SCHED;
            PG8_LDB(B0, 1, 0); PG8_LDB(B1, 1, 1); PG8_SCHED; PG8_LDA(At, 1, 0); PG8_STAGE(PG8_SA(0, 1), a2 + hstep, voffA);
            PG8_WAIT_V(8); PG8_WAIT_L(0); PG8_BAR; PG8_MMA(0, 0, At, B0); PG8_MMA(0, 1, At, B1); PG8_BAR; PG8_SCHED;
            PG8_LDA(At, 1, 1); PG8_STAGE(PG8_SB(1, 0), b3, voffB); PG8_STAGE(PG8_SB(1, 1), b3 + hstep, voffB); PG8_STAGE(PG8_SA(1, 0), a3, voffA);
            PG8_WAIT_V(8); PG8_WAIT_L(0); PG8_BAR; PG8_MMA(1, 0, At, B0); PG8_MMA(1, 1, At, B1); PG8_BAR; PG8_SCHED;
            } else {
            PG8_LDB(B0, 0, 0); PG8_SCHED; PG8_LDA(At, 0, 0); PG8_STAGE(PG8_SA(1, 1), a1 + hstep, voffA);
            PG8_WAIT_L(8); PG8_BAR; PG8_WAIT_L(0); PG8_MMA(0, 0, At, B0); PG8_BAR; PG8_SCHED;
            PG8_LDB(B1, 0, 1); PG8_STAGE(PG8_SB(0, 0), b2, voffB);
            PG8_BAR; PG8_WAIT_L(0); PG8_MMA(0, 1, At, B1); PG8_BAR;
            PG8_LDA(At, 0, 1); PG8_STAGE(PG8_SA(0, 0), a2, voffA);
            PG8_BAR; PG8_WAIT_L(0); PG8_MMA(1, 0, At, B0); PG8_BAR; PG8_SCHED;
            PG8_STAGE(PG8_SB(0, 1), b2 + hstep, voffB);
            PG8_WAIT_V(6); PG8_BAR; PG8_MMA(1, 1, At, B1); PG8_BAR;
            PG8_LDB(B0, 1, 0); PG8_SCHED; PG8_LDA(At, 1, 0); PG8_STAGE(PG8_SA(0, 1), a2 + hstep, voffA);
            PG8_WAIT_L(8); PG8_BAR; PG8_WAIT_L(0); PG8_MMA(0, 0, At, B0); PG8_BAR; PG8_SCHED;
            PG8_LDB(B1, 1, 1); PG8_STAGE(PG8_SB(1, 0), b3, voffB);
            PG8_BAR; PG8_WAIT_L(0); PG8_MMA(0, 1, At, B1); PG8_BAR;
            PG8_LDA(At, 1, 1); PG8_STAGE(PG8_SA(1, 0), a3, voffA);
            PG8_BAR; PG8_WAIT_L(0); PG8_MMA(1, 0, At, B0); PG8_BAR; PG8_SCHED;
            PG8_STAGE(PG8_SB(1, 1), b3 + hstep, voffB);
            PG8_WAIT_V(6); PG8_BAR; PG8_MMA(1, 1, At, B1); PG8_BAR;
            }
        }
        if constexpr (ALIGN_EPI) { if (wr == 0) PG8_BAR; }
        if constexpr (!Epi::AFTER_DRAIN) { E(acc, cur, wr, wc, fr, fq); S.done(cur); }
        if (!has_next) break;
#pragma unroll
        for (int a = 0; a < 2; ++a)
#pragma unroll
            for (int b = 0; b < 2; ++b)
#pragma unroll
                for (int m = 0; m < 4; ++m)
#pragma unroll
                    for (int n = 0; n < 2; ++n) acc[a][b][m][n] = (f32x4){0.f, 0.f, 0.f, 0.f};
        cur = nxt; cA = nA; cB = nB; ++ui;
        if constexpr (ALIGN_EPI) { if (wr == 1) PG8_BAR; }
    }
    PG8_WAIT_V(0);
    if constexpr (!ALIGN_EPI) { if (wr == 0) PG8_BAR; }
    PG8_BAR;
    if constexpr (Epi::AFTER_DRAIN) { E.fused(acc, cur, wr, wc, fr, fq, lds, wid, lane); S.done(cur); }
#undef PG8_SA
#undef PG8_SB
#undef PG8_STAGE
#undef PG8_LDA
#undef PG8_LDB
#undef PG8_MMA
#undef PG8_WAIT_V
#undef PG8_WAIT_L
#undef PG8_BAR
#undef PG8_SCHED
}
}

#ifndef PG8_SP2
#define PG8_SP2 true
#endif
#ifndef PG8_ALIGN
#define PG8_ALIGN true
#endif
constexpr int NWAVES = 8;
#ifndef MK_N_LAUNCHES
#define MK_N_LAUNCHES 10
#endif
constexpr int PER_PHASE = 10;
constexpr int N_LAUNCHES = MK_N_LAUNCHES;

constexpr int BATCH = 2, SEQ = 8192, D = 1024, M = BATCH * SEQ;
constexpr int NHEAD = 16, NKV = 4, HD = 64;
constexpr int SSMW = 2048, SH = 32, SG = 4, SR = 8, SP = 64, SN = 128, XBCW = 3072, CH = 128, NCH = SEQ / CH;
constexpr int IN_W = 9760, N_MAIN = 31 * 256, N_GATE = 2048, N_INT = N_MAIN + N_GATE;
constexpr float EPS = 1e-6f;

constexpr size_t MiB = 1u << 20;
constexpr size_t WS_CTL = 0, CTL_ZERO_BYTES = 64 * 1024;
constexpr size_t WS_WIN = 1 * MiB;
constexpr size_t WS_WA = WS_WIN + (size_t)N_INT * D * 2;
constexpr size_t WS_WS = WS_WA + 2 * MiB;
constexpr size_t WS_WO = WS_WS + 4 * MiB;
constexpr size_t WS_MISC = WS_WO + 2 * MiB;
constexpr size_t WS_DT = 29 * MiB;
constexpr size_t WS_XN = 32 * MiB;
constexpr size_t WS_Q = 64 * MiB;
constexpr size_t WS_ZM = 96 * MiB;
constexpr size_t WS_XBC = 160 * MiB;
constexpr size_t WS_GA = 160 * MiB, WS_GB = 192 * MiB, WS_MG = 224 * MiB, WS_END = 256 * MiB;
static_assert(WS_MISC + 64 * 1024 <= WS_DT && WS_DT + (size_t)M * 32 * 4 <= WS_XN, "ws map");
constexpr size_t OUT_K = 0, OUT_V = 8 * MiB, OUT_ZA = 16 * MiB, OUT_ST = 0;

constexpr int CW_BAR = 4096;

constexpr int RING_OFF = 0, RING_BYTES = 131072;
constexpr int LDSCTL_OFF = RING_BYTES, MISC_OFF = LDSCTL_OFF + 320;
constexpr int SMALL_OFF = RING_BYTES + 1024;
constexpr int LDS_BYTES = 147456;

#define GAS __attribute__((address_space(1)))
#define LAS __attribute__((address_space(3)))
typedef unsigned short bf16;
typedef unsigned v4u __attribute__((ext_vector_type(4)));
typedef float f32x4 __attribute__((ext_vector_type(4)));
typedef short bf16x8 __attribute__((ext_vector_type(8)));
typedef GAS unsigned gu32;
typedef GAS unsigned long long gu64;
#define RLX_AGENT __ATOMIC_RELAXED, __HIP_MEMORY_SCOPE_AGENT
#define LDS_WAIT() asm volatile("s_waitcnt lgkmcnt(0)" ::: "memory")
#define VM_WAIT() asm volatile("s_waitcnt vmcnt(0)" ::: "memory")
__device__ __forceinline__ unsigned long long rt() { return __builtin_amdgcn_s_memrealtime(); }
__device__ __forceinline__ unsigned f2bf(float f) { unsigned u = __builtin_bit_cast(unsigned, f); return (u + 0x7fffu + ((u >> 16) & 1u)) >> 16; }
__device__ __forceinline__ unsigned pk2(float lo, float hi) { return f2bf(lo) | (f2bf(hi) << 16); }

#define XB_TMO      128
#define XB_XCNT(j)  (256  + 64 * (j))
#define XB_XSUB(j)  (1280 + 64 * (j))
#define XB_XGEN(j)  (2304 + 64 * (j))
#define XB_TOP      3328
#define XB_TOPGEN   3392
#define XCD_BAR_WORDS 3456
#define XB_SPIN_CAP (1u << 18)

__device__ __forceinline__ unsigned xb_ld(unsigned* p)              { return __hip_atomic_load(p, __ATOMIC_RELAXED, __HIP_MEMORY_SCOPE_AGENT); }
__device__ __forceinline__ unsigned xb_add(unsigned* p, unsigned v) { return __hip_atomic_fetch_add(p, v, __ATOMIC_RELAXED, __HIP_MEMORY_SCOPE_AGENT); }
__device__ __forceinline__ unsigned xb_xcc_id() { return (unsigned)__builtin_amdgcn_s_getreg((3 << 11) | 20) & 0xFu; }
#define XB_SPIN(cond, bar) do { unsigned _sp = 0; while (cond) { __builtin_amdgcn_s_sleep(1); \
    if ((++_sp & 255u) == 0u) { if (xb_ld(&(bar)[XB_TMO])) break; if (_sp > XB_SPIN_CAP) { atomicAdd(&(bar)[XB_TMO], 1u); break; } } } } while (0)

struct XcdBarrier {
    unsigned* bar; unsigned x;
    volatile LAS unsigned* st;
};

__device__ __forceinline__ XcdBarrier xcd_barrier_post(unsigned* bar, volatile LAS unsigned* st) {
    XcdBarrier b; b.bar = bar; b.x = xb_xcc_id(); b.st = st;
    if (threadIdx.x == 0) (void)xb_add(&bar[XB_XCNT(b.x)], 1u);
    return b;
}
__device__ __forceinline__ void xcd_barrier_complete(unsigned* bar, unsigned x, unsigned& nloc, unsigned& nx) {
    const unsigned G = gridDim.x * gridDim.y * gridDim.z;
    unsigned sum, cnt, mine, sp = 0u;
    for (;;) {
        sum = 0u; cnt = 0u; mine = 0u;
#pragma unroll
        for (unsigned j = 0; j < 16; ++j) { const unsigned c = xb_ld(&bar[XB_XCNT(j)]); sum += c; cnt += (c > 0u) ? 1u : 0u; mine = (j == x) ? c : mine; }
        if (sum == G) break;
        __builtin_amdgcn_s_sleep(1);
        if ((++sp & 255u) == 0u) { if (xb_ld(&bar[XB_TMO])) break; if (sp > XB_SPIN_CAP) { atomicAdd(&bar[XB_TMO], 1u); break; } }
    }
    nloc = mine > 0u ? mine : 1u; nx = cnt > 0u ? cnt : 1u;
}

__device__ __forceinline__ void xcd_barrier(const XcdBarrier& b) {
    asm volatile("s_waitcnt vmcnt(0)" ::: "memory");
    __syncthreads();
    if (threadIdx.x == 0) {
        unsigned* bar = b.bar;
        __builtin_amdgcn_s_waitcnt(0);
        unsigned nloc = b.st[0], nx = b.st[1];
        if (nloc == 0u) { xcd_barrier_complete(bar, b.x, nloc, nx); b.st[0] = nloc; b.st[1] = nx; }
        const unsigned old = xb_add(&bar[XB_XSUB(b.x)], 1u);
        const unsigned gen = old / nloc;
        if (old + 1u == (gen + 1u) * nloc) {
            __builtin_amdgcn_fence(__ATOMIC_RELEASE, "agent");
            asm volatile("s_waitcnt vmcnt(0)" ::: "memory");
            const unsigned og = xb_add(&bar[XB_TOP], 1u);
            const unsigned tg = og / nx;
            if (og + 1u == (tg + 1u) * nx) xb_add(&bar[XB_TOPGEN], 1u);
            else XB_SPIN(xb_ld(&bar[XB_TOPGEN]) == tg, bar);
            __builtin_amdgcn_fence(__ATOMIC_ACQUIRE, "agent");
            xb_add(&bar[XB_XGEN(b.x)], 1u);
            asm volatile("s_waitcnt vmcnt(0)" ::: "memory");
        } else {
            XB_SPIN(xb_ld(&bar[XB_XGEN(b.x)]) == gen, bar);
            __builtin_amdgcn_fence(__ATOMIC_ACQUIRE, "agent");
            asm volatile("s_waitcnt vmcnt(0)" ::: "memory");
        }
    }
    __syncthreads();
}

struct Frame {
    LAS unsigned char* lds;
    volatile LAS unsigned* MISC;
    gu32* ctl;
    int tid, lane, wave;
    int vcu, G;
    const float *x, *c, *w_ada, *b_ada, *norm_w, *w_in, *q_norm_w, *k_norm_w, *rel_bias, *sinks, *conv_w, *conv_b, *dt_bias, *a_log, *d_skip, *ssm_norm_w, *w_attn, *w_ssm, *w_out;
    float* out;
    bf16 *WIN, *WA, *WS, *WO, *XN, *Q, *KB, *VB, *ZA, *ZM, *XBC, *GA, *GB, *MG, *ST;
    float *MOD, *CDEC, *DT;
};

__device__ __forceinline__ float wave_sum(float v) {
#pragma unroll
    for (int o = 1; o < 64; o <<= 1) v += __shfl_xor(v, o);
    return v;
}
__device__ __forceinline__ float bf2f(bf16 v) { return __uint_as_float((unsigned)v << 16); }
__device__ __forceinline__ float blo(unsigned w) { return __uint_as_float(w << 16); }
__device__ __forceinline__ float bhi(unsigned w) { return __uint_as_float(w & 0xffff0000u); }
__device__ __forceinline__ float silu_f(float v) { return v / (1.f + __expf(-v)); }
__device__ __forceinline__ int t5_bucket(int n) {
    if (n < 16) return n;
    const int l = 16 + (int)(log2f((float)n * 0.0625f) * (16.0f / 3.0f));
    return l < 31 ? l : 31;
}

__device__ __forceinline__ void p0_transpose_item(const float* W, int K, int N, bf16* WT, int row_off, LAS float* scr, int item, int lane) {
    const int nblk = N / 32, kb = item / nblk, nb = item % nblk, k0 = 64 * kb, n0 = 32 * nb;
#pragma unroll 8
    for (int i = 0; i < 32; ++i) { const int kk = 2 * i + (lane >> 5); scr[kk * 33 + (lane & 31)] = W[(size_t)(k0 + kk) * N + n0 + (lane & 31)]; }
    LDS_WAIT(); asm volatile("" ::: "memory");
    const int c = lane & 7;
#pragma unroll
    for (int j = 0; j < 4; ++j) { const int n = (lane >> 3) + 8 * j; const LAS float* s = scr + (8 * c) * 33 + n;
        v4u o; o.x = pk2(s[0 * 33], s[1 * 33]); o.y = pk2(s[2 * 33], s[3 * 33]); o.z = pk2(s[4 * 33], s[5 * 33]); o.w = pk2(s[6 * 33], s[7 * 33]);
        *(GAS v4u*)(WT + (size_t)(row_off + n0 + n) * K + k0 + 8 * c) = o; }
    LDS_WAIT(); asm volatile("" ::: "memory");
}

__device__ __forceinline__ void p0_prologue(Frame& F) {
    LAS float* scr = (LAS float*)(F.lds + RING_OFF + F.wave * 16384);
    const int gw = F.vcu * NWAVES + F.wave, NGW = F.G * NWAVES;
    constexpr int I_IN = (D / 64) * (IN_W / 32), I_A = (D / 64) * (D / 32), I_S = (SSMW / 64) * (D / 32), I_O = I_A;
    constexpr int NITEMS = I_IN + I_A + I_S + I_O;
    for (int it = gw; it < NITEMS; it += NGW) {
        int r = it;
        if (r < I_IN) { const int nb = r % (IN_W / 32); p0_transpose_item(F.w_in, D, IN_W, F.WIN, nb >= 241 ? 224 : 0, scr, r, F.lane); continue; } r -= I_IN;
        if (r < I_A) { p0_transpose_item(F.w_attn, D, D, F.WA, 0, scr, r, F.lane); continue; } r -= I_A;
        if (r < I_S) { p0_transpose_item(F.w_ssm, SSMW, D, F.WS, 0, scr, r, F.lane); continue; } r -= I_S;
        p0_transpose_item(F.w_out, D, D, F.WO, 0, scr, r, F.lane);
    }
    {
        GAS v4u* z = (GAS v4u*)(F.WIN + (size_t)7712 * D); const int n16 = 224 * D * 2 / 16;
        for (int i = F.vcu * 512 + F.tid; i < n16; i += F.G * 512) z[i] = (v4u){0u, 0u, 0u, 0u};
    }
    __syncthreads();
    LAS float* red = (LAS float*)(F.lds + RING_OFF);
    for (int u = F.vcu; u < 48; u += F.G) {
        const int n = u * 64 + (F.tid & 63), ks = F.tid >> 6;
        float a0 = 0.f, a1 = 0.f;
        for (int k = ks * 128; k < ks * 128 + 128; ++k) { const float w = F.w_ada[(size_t)k * 3072 + n]; a0 += silu_f(F.c[k]) * w; a1 += silu_f(F.c[1024 + k]) * w; }
        red[(ks * 64 + (F.tid & 63)) * 2] = a0; red[(ks * 64 + (F.tid & 63)) * 2 + 1] = a1;
        __syncthreads();
        if (F.tid < 128) { const int b = F.tid >> 6, cc = F.tid & 63; float s = F.b_ada[u * 64 + cc];
            for (int k2 = 0; k2 < 8; ++k2) s += red[(k2 * 64 + cc) * 2 + b];
            F.MOD[b * 3072 + u * 64 + cc] = s; }
        __syncthreads();
    }
}

__device__ __forceinline__ void p1_norm(Frame& F) {
    const int gw = F.vcu * NWAVES + F.wave, NGW = F.G * NWAVES;
    for (int m = gw; m < M; m += NGW) {
        const int b = m >> 13;
        const GAS f32x4* xr = (const GAS f32x4*)(F.x + (size_t)m * D) + F.lane;
        f32x4 v[4]; float s = 0.f;
#pragma unroll
        for (int j = 0; j < 4; ++j) { v[j] = xr[64 * j]; s += (v[j].x * v[j].x + v[j].y * v[j].y) + (v[j].z * v[j].z + v[j].w * v[j].w); }
        const float rstd = 1.f / sqrtf(wave_sum(s) * (1.f / D) + EPS);
        GAS unsigned long long* o8 = (GAS unsigned long long*)(F.XN + (size_t)m * D) + F.lane;
#pragma unroll
        for (int j = 0; j < 4; ++j) { const int cidx = 4 * F.lane + 256 * j;
            const f32x4 nw = *(const f32x4*)(F.norm_w + cidx), sh = *(const f32x4*)(F.MOD + b * 3072 + cidx), sc = *(const f32x4*)(F.MOD + b * 3072 + 1024 + cidx);
            const f32x4 h = v[j] * rstd * nw * (sc + 1.0f) + sh;
            o8[64 * j] = (unsigned long long)pk2(h.x, h.y) | ((unsigned long long)pk2(h.z, h.w) << 32); }
    }
}

__device__ __forceinline__ float conv_at(const bf16* XBC, const float* cw, const float* cb, int b, int t, int col) {
    float a = cb[col];
#pragma unroll
    for (int j = 0; j < 4; ++j) { const int tt = t - 3 + j; if (tt >= 0) a += cw[j * XBCW + col] * bf2f(XBC[((size_t)b * SEQ + tt) * XBCW + col]); }
    return silu_f(a);
}

__device__ __forceinline__ void p3_attn_naive(Frame& F) {
    const int gtid = F.vcu * 512 + F.tid, NT = F.G * 512;
    for (int p = gtid; p < NHEAD * M; p += NT) {
        const int head = p >> 14, token = p & (M - 1), t = token & (SEQ - 1), hk = head >> 2;
        const bf16* qp = F.Q + (size_t)token * D + head * HD;
        float qw[64]; float ss = 0.f;
#pragma unroll
        for (int i = 0; i < 8; ++i) { const v4u w = *(const GAS v4u*)(qp + 8 * i);
            qw[8 * i] = blo(w.x); qw[8 * i + 1] = bhi(w.x); qw[8 * i + 2] = blo(w.y); qw[8 * i + 3] = bhi(w.y); qw[8 * i + 4] = blo(w.z); qw[8 * i + 5] = bhi(w.z); qw[8 * i + 6] = blo(w.w); qw[8 * i + 7] = bhi(w.w); }
#pragma unroll
        for (int d = 0; d < 64; ++d) ss += qw[d] * qw[d];
        const float qs = 0.125f / sqrtf(ss * (1.f / 64.f) + EPS);
#pragma unroll
        for (int d = 0; d < 64; ++d) qw[d] *= qs * F.q_norm_w[d] * F.k_norm_w[d];
        float mx = F.sinks[head], l = 1.f; float acc[64];
#pragma unroll
        for (int d = 0; d < 64; ++d) acc[d] = 0.f;
        const int nd = t + 1 < 128 ? t + 1 : 128;
        for (int dist = 0; dist < nd; ++dist) {
            const size_t krow = (size_t)(token - dist);
            const bf16* kp = F.KB + krow * 256 + hk * HD;
            float kss = 0.f, dot = 0.f;
#pragma unroll
            for (int i = 0; i < 8; ++i) { const v4u w = *(const GAS v4u*)(kp + 8 * i);
                const float k0 = blo(w.x), k1 = bhi(w.x), k2 = blo(w.y), k3 = bhi(w.y), k4 = blo(w.z), k5 = bhi(w.z), k6 = blo(w.w), k7 = bhi(w.w);
                kss += (k0 * k0 + k1 * k1) + (k2 * k2 + k3 * k3) + (k4 * k4 + k5 * k5) + (k6 * k6 + k7 * k7);
                dot += qw[8 * i] * k0 + qw[8 * i + 1] * k1 + qw[8 * i + 2] * k2 + qw[8 * i + 3] * k3 + qw[8 * i + 4] * k4 + qw[8 * i + 5] * k5 + qw[8 * i + 6] * k6 + qw[8 * i + 7] * k7; }
            const float s = dot / sqrtf(kss * (1.f / 64.f) + EPS) + F.rel_bias[t5_bucket(dist) * NHEAD + head];
            if (s > mx) { const float f = __expf(mx - s); l *= f;
#pragma unroll
                for (int d = 0; d < 64; ++d) acc[d] *= f;
                mx = s; }
            const float pe = __expf(s - mx); l += pe;
            const bf16* vp = F.VB + krow * 256 + hk * HD;
#pragma unroll
            for (int i = 0; i < 8; ++i) { const v4u w = *(const GAS v4u*)(vp + 8 * i);
                acc[8 * i] += pe * blo(w.x); acc[8 * i + 1] += pe * bhi(w.x); acc[8 * i + 2] += pe * blo(w.y); acc[8 * i + 3] += pe * bhi(w.y);
                acc[8 * i + 4] += pe * blo(w.z); acc[8 * i + 5] += pe * bhi(w.z); acc[8 * i + 6] += pe * blo(w.w); acc[8 * i + 7] += pe * bhi(w.w); }
        }
        const float inv = 1.f / l;
        const bf16* zp = F.ZA + (size_t)token * D + head * HD; bf16* op = F.Q + (size_t)token * D + head * HD;
#pragma unroll
        for (int i = 0; i < 8; ++i) { const v4u z = *(const GAS v4u*)(zp + 8 * i); v4u o;
            o.x = pk2(acc[8 * i] * inv * blo(z.x), acc[8 * i + 1] * inv * bhi(z.x)); o.y = pk2(acc[8 * i + 2] * inv * blo(z.y), acc[8 * i + 3] * inv * bhi(z.y));
            o.z = pk2(acc[8 * i + 4] * inv * blo(z.z), acc[8 * i + 5] * inv * bhi(z.z)); o.w = pk2(acc[8 * i + 6] * inv * blo(z.w), acc[8 * i + 7] * inv * bhi(z.w));
            *(GAS v4u*)(op + 8 * i) = o; }
    }
}

__device__ __forceinline__ void p4_states_naive(Frame& F) {
    LAS float* Xw = (LAS float*)(F.lds + RING_OFF);
    LAS float* Bs = (LAS float*)(F.lds + RING_OFF + 32768);
    LAS float* sdt = (LAS float*)(F.lds + SMALL_OFF);
    LAS float* sac = sdt + 128;
    for (int u = F.vcu; u < BATCH * NCH * SH; u += F.G) {
        const int h = u & 31, c = (u >> 5) & 63, b = u >> 11, g = h >> 3;
        const int t0 = c * CH; const size_t row0 = (size_t)b * SEQ + t0;
        const float a = -__expf(F.a_log[h]);
        if (F.tid < 128) sdt[F.tid] = F.DT[(row0 + F.tid) * 32 + h];
        __syncthreads();
        if (F.tid == 0) { float s = 0.f; for (int l = 0; l < 128; ++l) { s += sdt[l] * a; sac[l] = s; } F.CDEC[u] = __expf(s); }
        __syncthreads();
        const float aend = sac[127];
        for (int i = F.tid; i < 128 * 64; i += 512) { const int l = i >> 6, p = i & 63;
            Xw[i] = conv_at(F.XBC, F.conv_w, F.conv_b, b, t0 + l, h * 64 + p) * sdt[l] * __expf(aend - sac[l]); }
        for (int i = F.tid; i < 128 * 128; i += 512) { const int l = i >> 7, n = i & 127;
            Bs[i] = conv_at(F.XBC, F.conv_w, F.conv_b, b, t0 + l, SSMW + g * SN + n); }
        __syncthreads();
        { const int p = F.tid >> 3, n0 = (F.tid & 7) * 16; float acc[16];
#pragma unroll
          for (int j = 0; j < 16; ++j) acc[j] = 0.f;
          for (int l = 0; l < 128; ++l) { const float xw = Xw[l * 64 + p];
#pragma unroll
              for (int j = 0; j < 16; ++j) acc[j] += xw * Bs[l * 128 + n0 + j]; }
          bf16* sp = F.ST + ((size_t)u * 64 + p) * 128 + n0;
          v4u o0, o1; o0.x = pk2(acc[0], acc[1]); o0.y = pk2(acc[2], acc[3]); o0.z = pk2(acc[4], acc[5]); o0.w = pk2(acc[6], acc[7]);
          o1.x = pk2(acc[8], acc[9]); o1.y = pk2(acc[10], acc[11]); o1.z = pk2(acc[12], acc[13]); o1.w = pk2(acc[14], acc[15]);
          *(GAS v4u*)sp = o0; *(GAS v4u*)(sp + 8) = o1; }
        __syncthreads();
    }
}

__device__ __forceinline__ void p5_scan(Frame& F) {
    const int gtid = F.vcu * 512 + F.tid, NT = F.G * 512;
    for (int e = gtid; e < BATCH * SH * 8192 / 2; e += NT) {
        const int bh = e >> 12, pn = (e & 4095) * 2, b = bh >> 5, h = bh & 31;
        float r0 = 0.f, r1 = 0.f;
        for (int c = 0; c < NCH; ++c) {
            const int u = (b * NCH + c) * SH + h;
            GAS unsigned* sp = (GAS unsigned*)(F.ST + (size_t)u * 8192 + pn);
            const unsigned w = *sp; const float dec = F.CDEC[u];
            *sp = pk2(r0, r1);
            r0 = r0 * dec + blo(w); r1 = r1 * dec + bhi(w);
        }
    }
}

__device__ __forceinline__ void p6_scan_naive(Frame& F) {
    LAS bf16* Cb = (LAS bf16*)(F.lds + RING_OFF);
    LAS bf16* Bb = (LAS bf16*)(F.lds + RING_OFF + 32768);
    LAS float* X = (LAS float*)(F.lds + RING_OFF + 65536);
    LAS bf16* Gm = (LAS bf16*)(F.lds + RING_OFF + 98304);
    LAS float* sdt = (LAS float*)(F.lds + SMALL_OFF);
    LAS float* sac = sdt + 128;
    LAS float* ssq = sdt + 256;
    for (int u = F.vcu; u < BATCH * NCH * SG; u += F.G) {
        const int g = u & 3, c = (u >> 2) & 63, b = u >> 8;
        const int t0 = c * CH; const size_t row0 = (size_t)b * SEQ + t0;
        for (int i = F.tid; i < 128 * 128; i += 512) { const int l = i >> 7, n = i & 127;
            Bb[i] = (bf16)f2bf(conv_at(F.XBC, F.conv_w, F.conv_b, b, t0 + l, SSMW + g * SN + n));
            Cb[i] = (bf16)f2bf(conv_at(F.XBC, F.conv_w, F.conv_b, b, t0 + l, SSMW + SG * SN + g * SN + n)); }
        if (F.tid < 128) ssq[F.tid] = 0.f;
        __syncthreads();
        for (int r = 0; r < SR; ++r) {
            const int h = g * SR + r; const float a = -__expf(F.a_log[h]);
            if (F.tid < 128) sdt[F.tid] = F.DT[(row0 + F.tid) * 32 + h];
            __syncthreads();
            if (F.tid == 0) { float s = 0.f; for (int l = 0; l < 128; ++l) { s += sdt[l] * a; sac[l] = s; } }
            for (int i = F.tid; i < 128 * 64; i += 512) { const int l = i >> 6, p = i & 63; X[i] = conv_at(F.XBC, F.conv_w, F.conv_b, b, t0 + l, h * 64 + p); }
            __syncthreads();
            { const int l = F.tid >> 2, s0 = (F.tid & 3) * 32;
              for (int s = s0; s < s0 + 32; ++s) { float v = 0.f;
                  if (s <= l) { float cb = 0.f; for (int n = 0; n < 128; ++n) cb += bf2f(Cb[l * 128 + n]) * bf2f(Bb[s * 128 + n]); v = cb * __expf(sac[l] - sac[s]) * sdt[s]; }
                  Gm[l * 128 + s] = (bf16)f2bf(v); } }
            __syncthreads();
            { const int l = F.tid >> 2, p0 = (F.tid & 3) * 16; float acc[16], off[16];
#pragma unroll
              for (int j = 0; j < 16; ++j) { acc[j] = 0.f; off[j] = 0.f; }
              for (int s = 0; s <= l; ++s) { const float gv = bf2f(Gm[l * 128 + s]);
#pragma unroll
                  for (int j = 0; j < 16; ++j) acc[j] += gv * X[s * 64 + p0 + j]; }
              const bf16* hp = F.ST + ((size_t)((b * NCH + c) * SH + h) * 64 + p0) * 128;
              for (int n = 0; n < 128; ++n) { const float cv = bf2f(Cb[l * 128 + n]);
#pragma unroll
                  for (int j = 0; j < 16; ++j) off[j] += cv * bf2f(hp[j * 128 + n]); }
              const float ea = __expf(sac[l]), dsk = F.d_skip[h]; float sq = 0.f;
              bf16* zp = F.ZM + (row0 + l) * SSMW + h * 64 + p0;
              unsigned ow[8];
#pragma unroll
              for (int j = 0; j < 16; j += 2) {
                  const unsigned zw = *(const GAS unsigned*)(zp + j);
                  const float y0 = (acc[j] + ea * off[j] + dsk * X[l * 64 + p0 + j]) * blo(zw), y1 = (acc[j + 1] + ea * off[j + 1] + dsk * X[l * 64 + p0 + j + 1]) * bhi(zw);
                  sq += y0 * y0 + y1 * y1; ow[j >> 1] = pk2(y0, y1); }
              *(GAS v4u*)zp = (v4u){ow[0], ow[1], ow[2], ow[3]}; *(GAS v4u*)(zp + 8) = (v4u){ow[4], ow[5], ow[6], ow[7]};
              atomicAdd((float*)(ssq + l), sq); }
            __syncthreads();
        }
        { const int l = F.tid >> 2, p0 = (F.tid & 3) * 16; const float rs = 1.f / sqrtf(ssq[l] * (1.f / 512.f) + EPS);
          for (int r = 0; r < SR; ++r) { const int col = (g * SR + r) * 64 + p0; bf16* zp = F.ZM + (row0 + l) * SSMW + col;
              const v4u a0 = *(const GAS v4u*)zp, a1 = *(const GAS v4u*)(zp + 8); const float* nw = F.ssm_norm_w + col; v4u o0, o1;
              o0.x = pk2(blo(a0.x) * rs * nw[0], bhi(a0.x) * rs * nw[1]); o0.y = pk2(blo(a0.y) * rs * nw[2], bhi(a0.y) * rs * nw[3]);
              o0.z = pk2(blo(a0.z) * rs * nw[4], bhi(a0.z) * rs * nw[5]); o0.w = pk2(blo(a0.w) * rs * nw[6], bhi(a0.w) * rs * nw[7]);
              o1.x = pk2(blo(a1.x) * rs * nw[8], bhi(a1.x) * rs * nw[9]); o1.y = pk2(blo(a1.y) * rs * nw[10], bhi(a1.y) * rs * nw[11]);
              o1.z = pk2(blo(a1.z) * rs * nw[12], bhi(a1.z) * rs * nw[13]); o1.w = pk2(blo(a1.w) * rs * nw[14], bhi(a1.w) * rs * nw[15]);
              *(GAS v4u*)zp = o0; *(GAS v4u*)(zp + 8) = o1; } }
        __syncthreads();
    }
}


struct Args { const float* in[19]; float* out; unsigned char* ws; int ph_lo, ph_hi, li, pad; };
__global__ void __launch_bounds__(NWAVES * 64, 2) mk_fwd(Args args) {
    extern __shared__ __attribute__((aligned(16))) unsigned char lds[];
    Frame F;
    F.lds = (LAS unsigned char*)lds;
    F.MISC = (volatile LAS unsigned*)(F.lds + MISC_OFF);
    F.tid = threadIdx.x; F.lane = F.tid & 63; F.wave = __builtin_amdgcn_readfirstlane(F.tid >> 6);
    F.G = gridDim.x; { const int bx = blockIdx.x; F.vcu = (F.G % 8 == 0) ? (bx % 8) * (F.G / 8) + bx / 8 : bx; }
    unsigned char* ws = args.ws;
    F.ctl = (gu32*)(ws + WS_CTL);
    F.x = args.in[0]; F.c = args.in[1]; F.w_ada = args.in[2]; F.b_ada = args.in[3]; F.norm_w = args.in[4]; F.w_in = args.in[5]; F.q_norm_w = args.in[6]; F.k_norm_w = args.in[7];
    F.rel_bias = args.in[8]; F.sinks = args.in[9]; F.conv_w = args.in[10]; F.conv_b = args.in[11]; F.dt_bias = args.in[12]; F.a_log = args.in[13]; F.d_skip = args.in[14];
    F.ssm_norm_w = args.in[15]; F.w_attn = args.in[16]; F.w_ssm = args.in[17]; F.w_out = args.in[18]; F.out = args.out;
    F.WIN = (bf16*)(ws + WS_WIN); F.WA = (bf16*)(ws + WS_WA); F.WS = (bf16*)(ws + WS_WS); F.WO = (bf16*)(ws + WS_WO);
    F.XN = (bf16*)(ws + WS_XN); F.Q = (bf16*)(ws + WS_Q); F.ZM = (bf16*)(ws + WS_ZM); F.XBC = (bf16*)(ws + WS_XBC);
    F.GA = (bf16*)(ws + WS_GA); F.GB = (bf16*)(ws + WS_GB); F.MG = (bf16*)(ws + WS_MG);
    F.KB = (bf16*)((unsigned char*)args.out + OUT_K); F.VB = (bf16*)((unsigned char*)args.out + OUT_V); F.ZA = (bf16*)((unsigned char*)args.out + OUT_ZA); F.ST = (bf16*)((unsigned char*)args.out + OUT_ST);
    F.MOD = (float*)(ws + WS_MISC); F.CDEC = (float*)(ws + WS_MISC + 32768); F.DT = (float*)(ws + WS_DT);
    for (int u = F.tid; u < (LDS_BYTES - LDSCTL_OFF) / 4; u += NWAVES * 64) ((LAS unsigned*)(F.lds + LDSCTL_OFF))[u] = 0u;
    __syncthreads();
    XcdBarrier bar; bar.bar = (unsigned*)(F.ctl + CW_BAR); bar.x = 0; bar.st = nullptr;
    if (N_LAUNCHES != PER_PHASE) bar = xcd_barrier_post((unsigned*)(F.ctl + CW_BAR), F.MISC + 8);
#define GRID_BAR() do { if (N_LAUNCHES != PER_PHASE) xcd_barrier(bar); } while (0)
    const int lo = args.ph_lo, hi = args.ph_hi;
#define IN(k) (lo <= (k) && (k) < hi)
#define BOTH(k) (IN(k) && IN((k) + 1))

    if (IN(0)) { p0_prologue(F); if (BOTH(0)) GRID_BAR(); }
    if (IN(1)) { p1_norm(F); if (BOTH(1)) GRID_BAR(); }
    if (IN(2)) {
        pg8::Gemm g{F.XN, F.WIN, M, N_MAIN, D}; pg8::StaticOrder S; S.init(M, N_MAIN, F.G, (int)blockIdx.x);
        pg8::EpiInProj E{F.Q, F.KB, F.VB, F.ZA, F.ZM, F.XBC, F.GA, F.GB, F.DT, F.dt_bias, 0};
        pg8::gemm_phase<pg8::EpiInProj, pg8::StaticOrder, PG8_ALIGN, PG8_SP2>(F.lds + RING_OFF, g, S, E);
        if (BOTH(2)) GRID_BAR();
    }
    if (IN(3)) { p3_attn_naive(F); if (BOTH(3)) GRID_BAR(); }
    if (IN(4)) { p4_states_naive(F); if (BOTH(4)) GRID_BAR(); }
    if (IN(5)) { p5_scan(F); if (BOTH(5)) GRID_BAR(); }
    if (IN(6)) { p6_scan_naive(F); if (BOTH(6)) GRID_BAR(); }
    if (IN(7)) {
        pg8::Gemm g{F.XN, F.WIN + (size_t)N_MAIN * D, M, N_GATE, D}; pg8::StaticOrder S; S.init(M, N_GATE, F.G, (int)blockIdx.x);
        pg8::EpiInProj E{F.Q, F.KB, F.VB, F.ZA, F.ZM, F.XBC, F.GA, F.GB, F.DT, F.dt_bias, 31};
        pg8::gemm_phase<pg8::EpiInProj, pg8::StaticOrder, PG8_ALIGN, PG8_SP2>(F.lds + RING_OFF, g, S, E);
        if (BOTH(7)) GRID_BAR();
    }
    if (IN(8)) {
        { pg8::Gemm g{F.Q, F.WA, M, D, D}; pg8::StaticOrder S; S.init(M, D, F.G, (int)blockIdx.x);
          pg8::EpiGate<0> E{F.GA, F.MG};
          pg8::gemm_phase<pg8::EpiGate<0>, pg8::StaticOrder, PG8_ALIGN, PG8_SP2>(F.lds + RING_OFF, g, S, E); }
        { pg8::Gemm g{F.ZM, F.WS, M, D, SSMW}; pg8::StaticOrder S; S.init(M, D, F.G, (int)blockIdx.x);
          pg8::EpiGate<1> E{F.GB, F.MG};
          pg8::gemm_phase<pg8::EpiGate<1>, pg8::StaticOrder, PG8_ALIGN, PG8_SP2>(F.lds + RING_OFF, g, S, E); }
        if (BOTH(8)) GRID_BAR();
    }
    if (IN(9)) {
        pg8::Gemm g{F.MG, F.WO, M, D, D}; pg8::StaticOrder S; S.init(M, D, F.G, (int)blockIdx.x);
        pg8::EpiOut E{F.x, F.MOD + 2048, F.out};
        pg8::gemm_phase<pg8::EpiOut, pg8::StaticOrder, PG8_ALIGN, PG8_SP2>(F.lds + RING_OFF, g, S, E);
    }
#undef IN
#undef BOTH
}

extern "C" void kernel_launch(void* const* d_in, const int* in_sizes, int n_in, void* d_out, int out_size, void* d_ws, size_t ws_size, hipStream_t stream) {
    static int grid = 0;
    if (grid == 0) {
        if (n_in != 19 || in_sizes[0] != M * D || out_size != M * D || ws_size < WS_END) { fprintf(stderr, "kernel_launch: unexpected shapes (n_in %d, in0 %d, out %d, ws %zu); nothing launched\n", n_in, n_in > 0 ? in_sizes[0] : -1, out_size, ws_size); grid = -1; return; }
        int dev = 0, cus = 0, per_cu = 0;
        if (hipGetDevice(&dev) != hipSuccess || hipDeviceGetAttribute(&cus, hipDeviceAttributeMultiprocessorCount, dev) != hipSuccess) { grid = -1; return; }
        if (hipFuncSetAttribute((const void*)mk_fwd, hipFuncAttributeMaxDynamicSharedMemorySize, LDS_BYTES) != hipSuccess) { fprintf(stderr, "kernel_launch: hipFuncSetAttribute failed\n"); grid = -1; return; }
        if (hipOccupancyMaxActiveBlocksPerMultiprocessor(&per_cu, (const void*)mk_fwd, NWAVES * 64, LDS_BYTES) != hipSuccess || per_cu < 1) { fprintf(stderr, "kernel_launch: occupancy query says %d blocks/CU\n", per_cu); }
        (void)hipGetLastError();
        grid = cus;
    }
    if (grid < 0) return;
    (void)hipMemsetAsync((char*)d_ws + WS_CTL, 0, CTL_ZERO_BYTES, stream);
    Args a{};
    for (int i = 0; i < 19; ++i) a.in[i] = (const float*)d_in[i];
    a.out = (float*)d_out; a.ws = (unsigned char*)d_ws;
    for (int li = 0; li < N_LAUNCHES; ++li) {
        a.ph_lo = (N_LAUNCHES == PER_PHASE) ? li : 0; a.ph_hi = (N_LAUNCHES == PER_PHASE) ? li + 1 : PER_PHASE; a.li = li;
        hipLaunchKernelGGL(mk_fwd, dim3(grid), dim3(NWAVES * 64), LDS_BYTES, stream, a);
    }
}
```

```cpp
#include <hip/hip_runtime.h>
#include <cstdio>
#include <cstdint>
#include <cmath>
namespace pg8 {
#define PG8_LAS __attribute__((address_space(3)))
typedef unsigned short bf16_t;
typedef short bf16x8 __attribute__((ext_vector_type(8)));
typedef float f32x4 __attribute__((ext_vector_type(4)));
typedef unsigned u32x4 __attribute__((ext_vector_type(4)));
constexpr int BM = 256, BK = 64, HALF = 128, HTB = HALF * BK * 2  , STAGE_BYTES = 8 * HTB, NXCD = 8, WGM = 8;

__host__ __device__ __forceinline__ int lds_byte(int r, int c) { const int st = (r >> 4) * 2 + (c >> 5), rr = r & 15, cc = c & 31, ob = rr * 64 + cc * 2; return st * 1024 + (ob ^ (((ob >> 9) & 1) << 5)); }
__host__ __device__ __forceinline__ void stage_rc(int b, int& R, int& C) { const int st = b / 1024, sb = b % 1024, swz = sb ^ (((sb >> 9) & 1) << 5); R = (st >> 1) * 16 + swz / 64; C = (st & 1) * 32 + (swz % 64) / 2; }
__host__ __device__ __forceinline__ int perm32(int rho) { const int n = rho >> 4, i = rho & 15; return 8 * (i >> 2) + 4 * n + (i & 3); }

struct Unit { int pm, pn; const bf16_t* A = nullptr; const bf16_t* B = nullptr; int mode = 0; int chain = 0; };
struct Gemm { const bf16_t* A; const bf16_t* Bt; int M, N, K; };

struct StaticOrder {
    int nM, nN, nwg, G, c;
    __host__ __device__ void init(int M, int N, int G_, int c_) { nM = M / BM; nN = N / BM; nwg = nM * nN; G = G_; c = c_; }
    __host__ __device__ bool next(int i, Unit& u) const {
        const long L = (long)i * G + c; if (L >= nwg) return false;
        int wgid = (int)L; { const int q = nwg / NXCD, r = nwg % NXCD, xcd = wgid % NXCD, off = wgid / NXCD; wgid = (xcd < r ? xcd * (q + 1) : r * (q + 1) + (xcd - r) * q) + off; }
        const int nig = WGM * nN, gid = wgid / nig, fm = gid * WGM, gsz = (nM - fm) < WGM ? (nM - fm) : WGM;
        u.pm = fm + ((wgid % nig) % gsz); u.pn = (wgid % nig) / gsz; return true;
    }
    __device__ __forceinline__ void a_ready(const Unit&) const {}
    __device__ __forceinline__ void done(const Unit&) const {}
};

__device__ __forceinline__ unsigned cvt_pk_bf16(float lo, float hi) { unsigned r; asm volatile("v_cvt_pk_bf16_f32 %0, %1, %2" : "=v"(r) : "v"(lo), "v"(hi)); return r; }
__device__ __forceinline__ float sigm(float v) { return __builtin_amdgcn_rcpf(1.f + __builtin_amdgcn_exp2f(-1.4426950408889634f * v)); }
__device__ __forceinline__ float bflo(unsigned w) { return __uint_as_float(w << 16); }
__device__ __forceinline__ float bfhi(unsigned w) { return __uint_as_float(w & 0xffff0000u); }

struct EpiInProj {
    static constexpr bool PERM = true, AFTER_DRAIN = false;
    bf16_t *Q, *Kb, *Vb, *ZA, *ZM, *XBC, *GA, *GB; float* DT; const float* dt_bias; int tile_off; bf16_t* HALO;
    __device__ __forceinline__ void operator()(const f32x4 (&acc)[2][2][4][2], const Unit& u, int wr, int wc, int fr, int fq) const {
        const int pn = u.pn + tile_off;
        const int row0 = u.pm * BM + wr * 64 + fr;
        if (pn == 30) {
            if (wc == 0) {
                const int c = 8 * fq;
                const f32x4 b0 = *(const f32x4*)(dt_bias + c), b1 = *(const f32x4*)(dt_bias + c + 4);
#pragma unroll
                for (int ai = 0; ai < 2; ++ai)
#pragma unroll
                    for (int m = 0; m < 4; ++m) {
                        const int r = row0 + ai * HALF + m * 16;
                        float* rp = DT + ((size_t)(r >> 7) * 32 + c) * 128 + (r & 127);
                        f32x4 v0 = acc[ai][0][m][0] + b0, v1 = acc[ai][0][m][1] + b1;
#pragma unroll
                        for (int j = 0; j < 4; ++j) { v0[j] = v0[j] > 15.f ? v0[j] : log1pf(__expf(v0[j])); v1[j] = v1[j] > 15.f ? v1[j] : log1pf(__expf(v1[j])); }
#pragma unroll
                        for (int j = 0; j < 4; ++j) { rp[j * 128] = v0[j]; rp[(4 + j) * 128] = v1[j]; }
                    }
            }
            return;
        }
        bf16_t* base; int ldc, c0, act;
        if (pn < 4) { base = Q; ldc = 1024; c0 = pn * 256; act = 0; }
        else if (pn == 4) { base = Kb; ldc = 256; c0 = 0; act = 0; }
        else if (pn == 5) { base = Vb; ldc = 256; c0 = 0; act = 0; }
        else if (pn < 10) { base = ZA; ldc = 1024; c0 = (pn - 6) * 256; act = 1; }
        else if (pn < 18) { base = ZM + (pn >= 14 ? (size_t)16384 * 1024 : 0); ldc = 1024; c0 = ((pn - 10) & 3) * 256; act = 1; }
        else if (pn < 30) { base = XBC; ldc = 3072; c0 = (pn - 18) * 256; act = 0; }
        else if (pn < 35) { base = GA; ldc = 1024; c0 = (pn - 31) * 256; act = 2; }
        else { base = GB; ldc = 1024; c0 = (pn - 35) * 256; act = 2; }
        const int col0 = c0 + wc * 32 + 8 * fq;
        const bool wthru = act != 2;
        const __amdgpu_buffer_rsrc_t rsrc = __builtin_amdgcn_make_buffer_rsrc((void*)base, (short)0, 0x7ffffff0, 0x00020000);
#pragma unroll
        for (int ai = 0; ai < 2; ++ai)
#pragma unroll
            for (int m = 0; m < 4; ++m) { bf16_t* rowp = base + (size_t)(row0 + ai * HALF + m * 16) * ldc + col0;
#pragma unroll
                for (int bj = 0; bj < 2; ++bj) { f32x4 v0 = acc[ai][bj][m][0], v1 = acc[ai][bj][m][1];
                    if (act == 1) {
#pragma unroll
                        for (int j = 0; j < 4; ++j) { v0[j] = v0[j] * sigm(v0[j]); v1[j] = v1[j] * sigm(v1[j]); } }
                    else if (act == 2) {
#pragma unroll
                        for (int j = 0; j < 4; ++j) { v0[j] = sigm(v0[j]); v1[j] = sigm(v1[j]); } }
                    u32x4 w; w.x = cvt_pk_bf16(v0[0], v0[1]); w.y = cvt_pk_bf16(v0[2], v0[3]); w.z = cvt_pk_bf16(v1[0], v1[1]); w.w = cvt_pk_bf16(v1[2], v1[3]);
                    if (wthru) __builtin_amdgcn_raw_buffer_store_b128(w, rsrc, (unsigned)(((row0 + ai * HALF + m * 16) * ldc + col0 + bj * HALF) * 2), 0,   16);
                    else *(u32x4*)(rowp + bj * HALF) = w;
                    if (pn >= 18 && pn < 26 && wr == 1 && m == 3 && fr >= 13) {
                        const int r = row0 + ai * HALF + m * 16;
                        *(u32x4*)(HALO + ((size_t)(r >> 7) * 3 + (fr - 13)) * 2048 + col0 + bj * HALF) = w; } } }
    }
};

template <int MODE> struct EpiGate {
    static constexpr bool PERM = true, AFTER_DRAIN = false;
    const bf16_t* G; bf16_t* O;
    __device__ __forceinline__ void operator()(const f32x4 (&acc)[2][2][4][2], const Unit& u, int wr, int wc, int fr, int fq) const {
        const int row0 = u.pm * BM + wr * 64 + fr, col0 = u.pn * BM + wc * 32 + 8 * fq;
#pragma unroll
        for (int ai = 0; ai < 2; ++ai)
#pragma unroll
            for (int m = 0; m < 4; ++m) { const size_t off = (size_t)(row0 + ai * HALF + m * 16) * 1024 + col0;
#pragma unroll
                for (int bj = 0; bj < 2; ++bj) { const f32x4 v0 = acc[ai][bj][m][0], v1 = acc[ai][bj][m][1];
                    const u32x4 g = *(const u32x4*)(G + off + bj * HALF);
                    float r[8];
                    r[0] = bflo(g.x) * v0[0]; r[1] = bfhi(g.x) * v0[1]; r[2] = bflo(g.y) * v0[2]; r[3] = bfhi(g.y) * v0[3];
                    r[4] = bflo(g.z) * v1[0]; r[5] = bfhi(g.z) * v1[1]; r[6] = bflo(g.w) * v1[2]; r[7] = bfhi(g.w) * v1[3];
                    if (MODE == 1) { const u32x4 o = *(const u32x4*)(O + off + bj * HALF);
                        r[0] += bflo(o.x); r[1] += bfhi(o.x); r[2] += bflo(o.y); r[3] += bfhi(o.y); r[4] += bflo(o.z); r[5] += bfhi(o.z); r[6] += bflo(o.w); r[7] += bfhi(o.w); }
                    u32x4 w; w.x = cvt_pk_bf16(r[0], r[1]); w.y = cvt_pk_bf16(r[2], r[3]); w.z = cvt_pk_bf16(r[4], r[5]); w.w = cvt_pk_bf16(r[6], r[7]);
                    *(u32x4*)(O + off + bj * HALF) = w; } }
    }
};

struct EpiOut {
    static constexpr bool PERM = false, AFTER_DRAIN = false;
    const float* x; const float* gate; const float* gbias; float* out;
    __device__ __forceinline__ void operator()(const f32x4 (&acc)[2][2][4][2], const Unit& u, int wr, int wc, int fr, int fq) const {
        const int row0 = u.pm * BM + wr * 64 + fr, col0 = u.pn * BM + wc * 32 + 4 * fq;
        const float* gb = gate + (size_t)((u.pm * BM) >> 13) * 3072;
#pragma unroll
        for (int bj = 0; bj < 2; ++bj)
#pragma unroll
            for (int n = 0; n < 2; ++n) { const int c = col0 + bj * HALF + n * 16; f32x4 gv = *(const f32x4*)(gbias + c);
#pragma unroll
                for (int k = 0; k < 4; ++k) gv[k] += __hip_atomic_load(gb + c + k, __ATOMIC_RELAXED, __HIP_MEMORY_SCOPE_AGENT);
#pragma unroll
                for (int ai = 0; ai < 2; ++ai)
#pragma unroll
                    for (int m = 0; m < 4; ++m) { const size_t off = (size_t)(row0 + ai * HALF + m * 16) * 1024 + c;
                        const f32x4 xv = *(const f32x4*)(x + off); *(f32x4*)(out + off) = xv + gv * acc[ai][bj][m][n]; } }
    }
};


struct ChainOrder {
    StaticOrder base; const bf16_t *ZM, *WS;
    __device__ bool next(int i, Unit& u) const {
        if (i >= 2) return false;
        if (!base.next(0, u)) return false;
        if (i == 0) { u.A = ZM; u.B = WS; u.mode = 3; u.chain = 1; }
        else { u.A = ZM + (size_t)16384 * 1024; u.B = WS + (size_t)1024 * 1024; u.mode = 4; u.chain = 0; }
        return true;
    }
    __device__ __forceinline__ void a_ready(const Unit&) const {}
    __device__ __forceinline__ void done(const Unit&) const {}
};

struct PairOrder {
    StaticOrder base;
    __device__ bool next(int i, Unit& u) const { if (i >= 2) return false; if (!base.next(0, u)) return false; u.pn += 4 * i; return true; }
    __device__ __forceinline__ void a_ready(const Unit&) const {}
    __device__ __forceinline__ void done(const Unit&) const {}
};
template <class Epi, class Sched, bool ALIGN_EPI = false, bool SP2 = false>
__device__ __forceinline__ void gemm_phase(PG8_LAS unsigned char* lds, const Gemm g, const Sched& S, const Epi& E) {
    const int tid = threadIdx.x, wid = __builtin_amdgcn_readfirstlane(tid >> 6), lane = tid & 63, wr = wid >> 2, wc = wid & 3, fr = lane & 15, fq = lane >> 4;
    const int K = g.K, nt = K / BK;
    unsigned voffA[2], voffB[2];
#pragma unroll
    for (int i = 0; i < 2; ++i) { int R, C; stage_rc(tid * 16 + i * 8192, R, C); const int Rb = Epi::PERM ? ((R & ~31) + perm32(R & 31)) : R;
        voffA[i] = (unsigned)(R * K + C) * 2u; voffB[i] = (unsigned)(Rb * K + C) * 2u; }
    const size_t kstep = (size_t)(BK * 2);
    const size_t hstep = (size_t)HALF * K * 2;
    const size_t tstep = 2 * hstep;
    const unsigned ldsw = (unsigned)wid * 1024u;
    const int aoff = lds_byte(wr * 64 + fr, fq * 8), boff = lds_byte(wc * 32 + fr, fq * 8);
#define PG8_SA(b, h) (((b) * 2 + (h)) * HTB)
#define PG8_SB(b, h) ((4 + (b) * 2 + (h)) * HTB)
#define PG8_STAGE(bufoff, gbase, voff) do { _Pragma("unroll") for (int _i = 0; _i < 2; ++_i) \
        __builtin_amdgcn_global_load_lds((const unsigned*)((const char*)(gbase) + (voff)[_i]), (PG8_LAS unsigned*)(lds + (bufoff) + ldsw + _i * 8192), 16, 0, 0); } while (0)
#define PG8_LDA(dst, b, h) do { _Pragma("unroll") for (int m = 0; m < 4; ++m) _Pragma("unroll") for (int k = 0; k < 2; ++k) dst[m][k] = *(const PG8_LAS bf16x8*)(lds + PG8_SA(b, h) + aoff + m * 2048 + k * 1024); } while (0)
#define PG8_LDB(dst, b, h) do { _Pragma("unroll") for (int n = 0; n < 2; ++n) _Pragma("unroll") for (int k = 0; k < 2; ++k) dst[n][k] = *(const PG8_LAS bf16x8*)(lds + PG8_SB(b, h) + boff + n * 2048 + k * 1024); } while (0)
#define PG8_MMA(ai, bj, At, Bt) do { __builtin_amdgcn_s_setprio(1); _Pragma("unroll") for (int m = 0; m < 4; ++m) _Pragma("unroll") for (int n = 0; n < 2; ++n) _Pragma("unroll") for (int k = 0; k < 2; ++k) \
        acc[ai][bj][m][n] = __builtin_amdgcn_mfma_f32_16x16x32_bf16(Bt[n][k], At[m][k], acc[ai][bj][m][n], 0, 0, 0); __builtin_amdgcn_s_setprio(0); } while (0)
#define PG8_WAIT_V(n) asm volatile("s_waitcnt vmcnt(" #n ")" ::: "memory")
#define PG8_WAIT_L(n) asm volatile("s_waitcnt lgkmcnt(" #n ")" ::: "memory")
#define PG8_BAR do { __builtin_amdgcn_s_barrier(); asm volatile("" ::: "memory"); } while (0)
#define PG8_SCHED __builtin_amdgcn_sched_barrier(0)
    Unit cur, nxt; int ui = 0;
    if (!S.next(0, cur)) return;
    f32x4 acc[2][2][4][2];
#pragma unroll
    for (int a = 0; a < 2; ++a)
#pragma unroll
        for (int b = 0; b < 2; ++b)
#pragma unroll
            for (int m = 0; m < 4; ++m)
#pragma unroll
                for (int n = 0; n < 2; ++n) acc[a][b][m][n] = (f32x4){0.f, 0.f, 0.f, 0.f};
    bf16x8 At[4][2], B0[2][2], B1[2][2];
    const char* cA = (const char*)(cur.A ? cur.A : g.A) + (size_t)cur.pm * tstep; const char* cB = (const char*)(cur.B ? cur.B : g.Bt) + (size_t)cur.pn * tstep;
    S.a_ready(cur);
    if constexpr (SP2) {
        PG8_STAGE(PG8_SB(0, 0), cB, voffB); PG8_STAGE(PG8_SB(0, 1), cB + hstep, voffB); PG8_STAGE(PG8_SA(0, 0), cA, voffA); PG8_STAGE(PG8_SA(0, 1), cA + hstep, voffA);
        if (wr == 1) PG8_BAR;
        PG8_WAIT_V(2); PG8_BAR;
        PG8_STAGE(PG8_SB(1, 0), cB + kstep, voffB); PG8_STAGE(PG8_SA(1, 0), cA + kstep, voffA); PG8_STAGE(PG8_SB(1, 1), cB + hstep + kstep, voffB);
        PG8_WAIT_V(6); PG8_BAR;
    } else {
        PG8_STAGE(PG8_SB(0, 0), cB, voffB); PG8_STAGE(PG8_SA(0, 0), cA, voffA); PG8_STAGE(PG8_SB(0, 1), cB + hstep, voffB); PG8_STAGE(PG8_SA(0, 1), cA + hstep, voffA);
        if (wr == 1) PG8_BAR;
        PG8_WAIT_V(4); PG8_BAR;
        PG8_STAGE(PG8_SB(1, 0), cB + kstep, voffB); PG8_STAGE(PG8_SA(1, 0), cA + kstep, voffA); PG8_STAGE(PG8_SB(1, 1), cB + hstep + kstep, voffB);
        PG8_WAIT_V(6); PG8_BAR;
    }
    for (;;) {
        const bool has_next = S.next(ui + 1, nxt);
        const char* nA = has_next ? (const char*)(nxt.A ? nxt.A : g.A) + (size_t)nxt.pm * tstep : cA; const char* nB = has_next ? (const char*)(nxt.B ? nxt.B : g.Bt) + (size_t)nxt.pn * tstep : cB;
        for (int t = 0; t < nt; t += 2) {
            const bool last = (t == nt - 2);
            const char* a1 = cA + (size_t)(t + 1) * kstep;
            const char* a2 = last ? nA : cA + (size_t)(t + 2) * kstep; const char* b2 = last ? nB : cB + (size_t)(t + 2) * kstep;
            const char* a3 = a2 + kstep; const char* b3 = b2 + kstep;
            if (last && has_next) S.a_ready(nxt);
            if constexpr (SP2) {
            PG8_LDB(B0, 0, 0); PG8_LDB(B1, 0, 1); PG8_SCHED; PG8_LDA(At, 0, 0); PG8_STAGE(PG8_SA(1, 1), a1 + hstep, voffA);
            PG8_WAIT_V(8); PG8_WAIT_L(0); PG8_BAR; PG8_MMA(0, 0, At, B0); PG8_MMA(0, 1, At, B1); PG8_BAR; PG8_SCHED;
            PG8_LDA(At, 0, 1); PG8_STAGE(PG8_SB(0, 0), b2, voffB); PG8_STAGE(PG8_SB(0, 1), b2 + hstep, voffB); PG8_STAGE(PG8_SA(0, 0), a2, voffA);
            PG8_WAIT_V(8); PG8_WAIT_L(0); PG8_BAR; PG8_MMA(1, 0, At, B0); PG8_MMA(1, 1, At, B1); PG8_BAR; PG8_SCHED;
            PG8_LDB(B0, 1, 0); PG8_LDB(B1, 1, 1); PG8_SCHED; PG8_LDA(At, 1, 0); PG8_STAGE(PG8_SA(0, 1), a2 + hstep, voffA);
            PG8_WAIT_V(8); PG8_WAIT_L(0); PG8_BAR; PG8_MMA(0, 0, At, B0); PG8_MMA(0, 1, At, B1); PG8_BAR; PG8_SCHED;
            PG8_LDA(At, 1, 1); PG8_STAGE(PG8_SB(1, 0), b3, voffB); PG8_STAGE(PG8_SB(1, 1), b3 + hstep, voffB); PG8_STAGE(PG8_SA(1, 0), a3, voffA);
            PG8_WAIT_V(8); PG8_WAIT_L(0); PG8_BAR; PG8_MMA(1, 0, At, B0); PG8_MMA(1, 1, At, B1); PG8_BAR; PG8_SCHED;
            } else {
            PG8_LDB(B0, 0, 0); PG8_SCHED; PG8_LDA(At, 0, 0); PG8_STAGE(PG8_SA(1, 1), a1 + hstep, voffA);
            PG8_WAIT_L(8); PG8_BAR; PG8_WAIT_L(0); PG8_MMA(0, 0, At, B0); PG8_BAR; PG8_SCHED;
            PG8_LDB(B1, 0, 1); PG8_STAGE(PG8_SB(0, 0), b2, voffB);
            PG8_BAR; PG8_WAIT_L(0); PG8_MMA(0, 1, At, B1); PG8_BAR;
            PG8_LDA(At, 0, 1); PG8_STAGE(PG8_SA(0, 0), a2, voffA);
            PG8_BAR; PG8_WAIT_L(0); PG8_MMA(1, 0, At, B0); PG8_BAR; PG8_SCHED;
            PG8_STAGE(PG8_SB(0, 1), b2 + hstep, voffB);
            PG8_WAIT_V(6); PG8_BAR; PG8_MMA(1, 1, At, B1); PG8_BAR;
            PG8_LDB(B0, 1, 0); PG8_SCHED; PG8_LDA(At, 1, 0); PG8_STAGE(PG8_SA(0, 1), a2 + hstep, voffA);
            PG8_WAIT_L(8); PG8_BAR; PG8_WAIT_L(0); PG8_MMA(0, 0, At, B0); PG8_BAR; PG8_SCHED;
            PG8_LDB(B1, 1, 1); PG8_STAGE(PG8_SB(1, 0), b3, voffB);
            PG8_BAR; PG8_WAIT_L(0); PG8_MMA(0, 1, At, B1); PG8_BAR;
            PG8_LDA(At, 1, 1); PG8_STAGE(PG8_SA(1, 0), a3, voffA);
            PG8_BAR; PG8_WAIT_L(0); PG8_MMA(1, 0, At, B0); PG8_BAR; PG8_SCHED;
            PG8_STAGE(PG8_SB(1, 1), b3 + hstep, voffB);
            PG8_WAIT_V(6); PG8_BAR; PG8_MMA(1, 1, At, B1); PG8_BAR;
            }
        }
        if constexpr (ALIGN_EPI) { if (wr == 0) PG8_BAR; }
        if constexpr (!Epi::AFTER_DRAIN) { if (!cur.chain) E(acc, cur, wr, wc, fr, fq); S.done(cur); }
        if (!has_next) break;
        if (!cur.chain)
#pragma unroll
        for (int a = 0; a < 2; ++a)
#pragma unroll
            for (int b = 0; b < 2; ++b)
#pragma unroll
                for (int m = 0; m < 4; ++m)
#pragma unroll
                    for (int n = 0; n < 2; ++n) acc[a][b][m][n] = (f32x4){0.f, 0.f, 0.f, 0.f};
        cur = nxt; cA = nA; cB = nB; ++ui;
        if constexpr (ALIGN_EPI) { if (wr == 1) PG8_BAR; }
    }
    PG8_WAIT_V(0);
    if constexpr (!ALIGN_EPI) { if (wr == 0) PG8_BAR; }
    PG8_BAR;
    if constexpr (Epi::AFTER_DRAIN) { E.fused(acc, cur, wr, wc, fr, fq, lds, wid, lane); S.done(cur); }
#undef PG8_SA
#undef PG8_SB
#undef PG8_STAGE
#undef PG8_LDA
#undef PG8_LDB
#undef PG8_MMA
#undef PG8_WAIT_V
#undef PG8_WAIT_L
#undef PG8_BAR
#undef PG8_SCHED
}
}

#ifndef PG8_SP2
#define PG8_SP2 true
#endif
#ifndef PG8_ALIGN
#define PG8_ALIGN true
#endif
constexpr int NWAVES = 8;
#ifndef MK_N_LAUNCHES
#define MK_N_LAUNCHES 1
#endif
constexpr int PER_PHASE = 10;
constexpr int N_LAUNCHES = MK_N_LAUNCHES;

constexpr int BATCH = 2, SEQ = 8192, D = 1024, M = BATCH * SEQ;
constexpr int NHEAD = 16, NKV = 4, HD = 64;
constexpr int SSMW = 2048, SH = 32, SG = 4, SR = 8, SP = 64, SN = 128, XBCW = 3072, CH = 128, NCH = SEQ / CH;
constexpr int IN_W = 9760, N_MAIN = 31 * 256, N_GATE = 2048, N_INT = N_MAIN + N_GATE;
constexpr float EPS = 1e-6f;

constexpr size_t MiB = 1u << 20;
constexpr size_t WS_CTL = 0, CTL_ZERO_BYTES = 64 * 1024;
constexpr size_t WS_WIN = 64 * 1024;
constexpr size_t WS_WA = WS_WIN + (size_t)N_INT * D * 2;
constexpr size_t WS_WS = WS_WA + 2 * MiB;
constexpr size_t WS_WO = WS_WS + 4 * MiB;
constexpr size_t WS_MISC = WS_WO + 2 * MiB;
constexpr size_t WS_DT = WS_MISC + 64 * 1024;
constexpr size_t WS_HALO = WS_DT + 2 * MiB;
constexpr size_t WS_XN = 32 * MiB;
constexpr size_t WS_Q = 64 * MiB;
constexpr size_t WS_ZM = 96 * MiB;
constexpr size_t WS_XBC = 160 * MiB;
constexpr size_t WS_GA = 160 * MiB, WS_GB = 192 * MiB, WS_MG = 224 * MiB, WS_END = 256 * MiB;
static_assert(WS_HALO + (size_t)(M / 128) * 3 * 2048 * 2 <= WS_XN, "ws map");
constexpr size_t OUT_K = 0, OUT_V = 8 * MiB, OUT_ZA = 16 * MiB, OUT_ST = 0;

constexpr int CW_MODCNT = 64;
constexpr int CW_BAR = 4096;

constexpr int RING_OFF = 0, RING_BYTES = 131072;
constexpr int LDSCTL_OFF = RING_BYTES, MISC_OFF = LDSCTL_OFF + 320;
constexpr int SMALL_OFF = RING_BYTES + 1024;
constexpr int LDS_BYTES = 147456;

#define GAS __attribute__((address_space(1)))
#define LAS __attribute__((address_space(3)))
typedef unsigned short bf16;
typedef unsigned v4u __attribute__((ext_vector_type(4)));
typedef float f32x4 __attribute__((ext_vector_type(4)));
typedef short bf16x8 __attribute__((ext_vector_type(8)));
typedef GAS unsigned gu32;
typedef GAS unsigned long long gu64;
#define RLX_AGENT __ATOMIC_RELAXED, __HIP_MEMORY_SCOPE_AGENT
#define LDS_WAIT() asm volatile("s_waitcnt lgkmcnt(0)" ::: "memory")
#define VM_WAIT() asm volatile("s_waitcnt vmcnt(0)" ::: "memory")
__device__ __forceinline__ unsigned long long rt() { return __builtin_amdgcn_s_memrealtime(); }
__device__ __forceinline__ unsigned f2bf(float f) { unsigned u = __builtin_bit_cast(unsigned, f); return (u + 0x7fffu + ((u >> 16) & 1u)) >> 16; }
__device__ __forceinline__ unsigned pk2(float lo, float hi) { return f2bf(lo) | (f2bf(hi) << 16); }

#define XB_TMO      128
#define XB_XCNT(j)  (256  + 64 * (j))
#define XB_XSUB(j)  (1280 + 64 * (j))
#define XB_XGEN(j)  (2304 + 64 * (j))
#define XB_TOP      3328
#define XB_TOPGEN   3392
#define XCD_BAR_WORDS 3456
#define XB_SPIN_CAP (1u << 18)

__device__ __forceinline__ unsigned xb_ld(unsigned* p)              { return __hip_atomic_load(p, __ATOMIC_RELAXED, __HIP_MEMORY_SCOPE_AGENT); }
__device__ __forceinline__ unsigned xb_add(unsigned* p, unsigned v) { return __hip_atomic_fetch_add(p, v, __ATOMIC_RELAXED, __HIP_MEMORY_SCOPE_AGENT); }
__device__ __forceinline__ unsigned xb_xcc_id() { return (unsigned)__builtin_amdgcn_s_getreg((3 << 11) | 20) & 0xFu; }
#define XB_SPIN(cond, bar) do { unsigned _sp = 0; while (cond) { __builtin_amdgcn_s_sleep(1); \
    if ((++_sp & 255u) == 0u) { if (xb_ld(&(bar)[XB_TMO])) break; if (_sp > XB_SPIN_CAP) { atomicAdd(&(bar)[XB_TMO], 1u); break; } } } } while (0)

struct XcdBarrier {
    unsigned* bar; unsigned x;
    volatile LAS unsigned* st;
};

__device__ __forceinline__ XcdBarrier xcd_barrier_post(unsigned* bar, volatile LAS unsigned* st) {
    XcdBarrier b; b.bar = bar; b.x = xb_xcc_id(); b.st = st;
    if (threadIdx.x == 0) (void)xb_add(&bar[XB_XCNT(b.x)], 1u);
    return b;
}
__device__ __forceinline__ void xcd_barrier_complete(unsigned* bar, unsigned x, unsigned& nloc, unsigned& nx) {
    const unsigned G = gridDim.x * gridDim.y * gridDim.z;
    unsigned sum, cnt, mine, sp = 0u;
    for (;;) {
        sum = 0u; cnt = 0u; mine = 0u;
#pragma unroll
        for (unsigned j = 0; j < 16; ++j) { const unsigned c = xb_ld(&bar[XB_XCNT(j)]); sum += c; cnt += (c > 0u) ? 1u : 0u; mine = (j == x) ? c : mine; }
        if (sum == G) break;
        __builtin_amdgcn_s_sleep(1);
        if ((++sp & 255u) == 0u) { if (xb_ld(&bar[XB_TMO])) break; if (sp > XB_SPIN_CAP) { atomicAdd(&bar[XB_TMO], 1u); break; } }
    }
    nloc = mine > 0u ? mine : 1u; nx = cnt > 0u ? cnt : 1u;
}

__device__ __forceinline__ void xcd_barrier(const XcdBarrier& b) {
    asm volatile("s_waitcnt vmcnt(0)" ::: "memory");
    __syncthreads();
    if (threadIdx.x == 0) {
        unsigned* bar = b.bar;
        __builtin_amdgcn_s_waitcnt(0);
        unsigned nloc = b.st[0], nx = b.st[1];
        if (nloc == 0u) { xcd_barrier_complete(bar, b.x, nloc, nx); b.st[0] = nloc; b.st[1] = nx; }
        const unsigned old = xb_add(&bar[XB_XSUB(b.x)], 1u);
        const unsigned gen = old / nloc;
        if (old + 1u == (gen + 1u) * nloc) {
            __builtin_amdgcn_fence(__ATOMIC_RELEASE, "agent");
            asm volatile("s_waitcnt vmcnt(0)" ::: "memory");
            const unsigned og = xb_add(&bar[XB_TOP], 1u);
            const unsigned tg = og / nx;
            if (og + 1u == (tg + 1u) * nx) xb_add(&bar[XB_TOPGEN], 1u);
            else XB_SPIN(xb_ld(&bar[XB_TOPGEN]) == tg, bar);
            __builtin_amdgcn_fence(__ATOMIC_ACQUIRE, "agent");
            xb_add(&bar[XB_XGEN(b.x)], 1u);
            asm volatile("s_waitcnt vmcnt(0)" ::: "memory");
        } else {
            XB_SPIN(xb_ld(&bar[XB_XGEN(b.x)]) == gen, bar);
            __builtin_amdgcn_fence(__ATOMIC_ACQUIRE, "agent");
            asm volatile("s_waitcnt vmcnt(0)" ::: "memory");
        }
    }
    __syncthreads();
}

struct Frame {
    LAS unsigned char* lds;
    volatile LAS unsigned* MISC;
    gu32* ctl;
    int tid, lane, wave;
    int vcu, G;
    const float *x, *c, *w_ada, *b_ada, *norm_w, *w_in, *q_norm_w, *k_norm_w, *rel_bias, *sinks, *conv_w, *conv_b, *dt_bias, *a_log, *d_skip, *ssm_norm_w, *w_attn, *w_ssm, *w_out;
    float* out;
    bf16 *WIN, *WA, *WS, *WO, *XN, *Q, *KB, *VB, *ZA, *ZM, *XBC, *GA, *GB, *MG, *ST, *HALO;
    float *MOD, *CDEC, *DT;
};

__device__ __forceinline__ float wave_sum(float v) {
#pragma unroll
    for (int o = 1; o < 64; o <<= 1) v += __shfl_xor(v, o);
    return v;
}
__device__ __forceinline__ float bf2f(bf16 v) { return __uint_as_float((unsigned)v << 16); }
__device__ __forceinline__ float blo(unsigned w) { return __uint_as_float(w << 16); }
__device__ __forceinline__ float bhi(unsigned w) { return __uint_as_float(w & 0xffff0000u); }
__device__ __forceinline__ float silu_f(float v) { return v / (1.f + __expf(-v)); }
__device__ __forceinline__ int t5_bucket(int n) {
    if (n < 16) return n;
    const int l = 16 + (int)(log2f((float)n * 0.0625f) * (16.0f / 3.0f));
    return l < 31 ? l : 31;
}

typedef short s16x4_ __attribute__((ext_vector_type(4)));
struct P0Item { const float* W; int K, N, row_off, Kd; bf16* WT; int item; };
__device__ __forceinline__ void p0_item_load(const P0Item& it, int lane, f32x4 (&v)[8]) {
    const int nblk = it.N / 32, kb = it.item / nblk, nb = it.item % nblk, k0 = 64 * kb, n0 = 32 * nb;
    const float* src = it.W + (size_t)(k0 + (lane >> 3)) * it.N + n0 + 4 * (lane & 7);
#pragma unroll
    for (int i = 0; i < 8; ++i) v[i] = __builtin_nontemporal_load((const GAS f32x4*)(src + (size_t)(8 * i) * it.N));
}
__device__ __forceinline__ void p0_item_finish(const P0Item& it, int lane, const f32x4 (&v)[8], LAS unsigned char* scr) {
    const int nblk = it.N / 32, kb = it.item / nblk, nb = it.item % nblk, k0 = 64 * kb, n0 = 32 * nb;
#pragma unroll
    for (int i = 0; i < 8; ++i) { unsigned long long w = (unsigned long long)pk2(v[i].x, v[i].y) | ((unsigned long long)pk2(v[i].z, v[i].w) << 32);
        *(LAS unsigned long long*)(scr + (8 * i + (lane >> 3)) * 192 + 8 * (lane & 7)) = w; }
    LDS_WAIT(); asm volatile("" ::: "memory");
    const int h = lane >> 5, blk = (lane >> 4) & 1, q = (lane & 15) >> 2, p = lane & 3;
    const LAS unsigned char* tb = scr + (8 * h + q) * 192 + 32 * blk + 8 * p;
    const int kd = it.Kd ? it.Kd : it.K;
    bf16* dst = it.WT + (size_t)(k0 / kd) * it.N * kd + (size_t)(it.row_off + n0 + (lane & 31)) * kd + (k0 % kd) + 8 * h;
#pragma unroll
    for (int ks = 0; ks < 4; ++ks) {
        const s16x4_ lo = __builtin_bit_cast(s16x4_, __builtin_amdgcn_ds_read_tr16_b64_v4i16((LAS s16x4_*)(tb + 16 * ks * 192)));
        const s16x4_ hi = __builtin_bit_cast(s16x4_, __builtin_amdgcn_ds_read_tr16_b64_v4i16((LAS s16x4_*)(tb + (16 * ks + 4) * 192)));
        const bf16x8 o = __builtin_shufflevector(lo, hi, 0, 1, 2, 3, 4, 5, 6, 7);
        *(GAS bf16x8*)(dst + 16 * ks) = o; }
    LDS_WAIT(); asm volatile("" ::: "memory");
}

__device__ __forceinline__ void p0_prologue(Frame& F) {
    LAS unsigned char* scr = F.lds + RING_OFF + F.wave * 12288;
    const int gw = F.vcu * NWAVES + F.wave, NGW = F.G * NWAVES;
    if (F.vcu < 96) {
        const int cg = F.vcu % 12, n = cg * 256 + 4 * F.lane, k0 = (F.vcu / 12) * 128 + 16 * F.wave;
        f32x4 wv[16];
#pragma unroll
        for (int i = 0; i < 16; ++i) wv[i] = __builtin_nontemporal_load((const GAS f32x4*)(F.w_ada + (size_t)(k0 + i) * 3072 + n));
        f32x4 a0 = {0.f, 0.f, 0.f, 0.f}, a1 = {0.f, 0.f, 0.f, 0.f};
#pragma unroll
        for (int i = 0; i < 16; ++i) { const float c0 = silu_f(F.c[k0 + i]), c1 = silu_f(F.c[1024 + k0 + i]); a0 += wv[i] * c0; a1 += wv[i] * c1; }
        LAS f32x4* part = (LAS f32x4*)(F.lds + RING_OFF + 8 * 12288);
        part[(F.wave * 2 + 0) * 64 + F.lane] = a0; part[(F.wave * 2 + 1) * 64 + F.lane] = a1;
        __syncthreads();
        { const int bb = F.tid >> 8, col = F.tid & 255; float sum = 0.f;
          const LAS float* pf = (const LAS float*)part;
#pragma unroll
          for (int w8 = 0; w8 < 8; ++w8) sum += pf[((w8 * 2 + bb) * 64) * 4 + col];
          atomicAdd(F.MOD + bb * 3072 + cg * 256 + col, sum); }
        asm volatile("s_waitcnt vmcnt(0)" ::: "memory");
        __syncthreads();
        if (F.tid == 0) __hip_atomic_fetch_add(F.ctl + CW_MODCNT, 1u, __ATOMIC_RELAXED, __HIP_MEMORY_SCOPE_AGENT);
    }
    {
        GAS v4u* z = (GAS v4u*)(F.WIN + (size_t)7712 * D); const int n16 = 224 * D * 2 / 16;
        for (int i = F.vcu * 512 + F.tid; i < n16; i += F.G * 512) z[i] = (v4u){0u, 0u, 0u, 0u};
    }
    constexpr int I_IN = (D / 64) * (IN_W / 32), I_A = (D / 64) * (D / 32), I_S = (SSMW / 64) * (D / 32), I_O = I_A;
    constexpr int NITEMS = I_IN + I_A + I_S + I_O;
#define P0_DESC(it_, d_) do { int r_ = (it_); \
        if (r_ < I_IN) { d_ = P0Item{F.w_in, D, IN_W, (r_ % (IN_W / 32)) >= 241 ? 224 : 0, 0, F.WIN, r_}; } \
        else if ((r_ -= I_IN) < I_A) { d_ = P0Item{F.w_attn, D, D, 0, 0, F.WA, r_}; } \
        else if ((r_ -= I_A) < I_S) { d_ = P0Item{F.w_ssm, SSMW, D, 0, D, F.WS, r_}; } \
        else { r_ -= I_S; d_ = P0Item{F.w_out, D, D, 0, 0, F.WO, r_}; } } while (0)
    const int gwt = ((F.vcu + F.G - 96) % F.G) * NWAVES + F.wave;
    for (int it = gwt; it < I_IN; it += 2 * NGW) {
        P0Item da, db; f32x4 va[8], vb[8];
        P0_DESC(it, da); p0_item_load(da, F.lane, va);
        const bool two = it + NGW < I_IN;
        if (two) { P0_DESC(it + NGW, db); p0_item_load(db, F.lane, vb); }
        p0_item_finish(da, F.lane, va, scr);
        if (two) p0_item_finish(db, F.lane, vb, scr);
    }
}
__device__ __forceinline__ void p0_late(Frame& F, int first_wg) {
    LAS unsigned char* scr = F.lds + RING_OFF + F.wave * 12288;
    constexpr int I_IN = (D / 64) * (IN_W / 32), I_A = (D / 64) * (D / 32), I_S = (SSMW / 64) * (D / 32), I_O = I_A;
    constexpr int NITEMS = I_IN + I_A + I_S + I_O;
    const int nw = (F.G - first_wg) * NWAVES, gw = ((int)blockIdx.x - first_wg) * NWAVES + F.wave;
    for (int it = I_IN + gw; it < NITEMS; it += 2 * nw) {
        P0Item da, db; f32x4 va[8], vb[8];
        P0_DESC(it, da); p0_item_load(da, F.lane, va);
        const bool two = it + nw < NITEMS;
        if (two) { P0_DESC(it + nw, db); p0_item_load(db, F.lane, vb); }
        p0_item_finish(da, F.lane, va, scr);
        if (two) p0_item_finish(db, F.lane, vb, scr);
    }
    __syncthreads();
}
#undef P0_DESC
__device__ __forceinline__ void p0_wait_mod(Frame& F) {
    unsigned spins = 0;
    while (__hip_atomic_load(F.ctl + CW_MODCNT, __ATOMIC_RELAXED, __HIP_MEMORY_SCOPE_AGENT) < 96u) { __builtin_amdgcn_s_sleep(8); if (++spins > (1u << 22)) break; }
}

__device__ __forceinline__ void p1_norm(Frame& F) {
    const int gw = F.vcu * NWAVES + F.wave, NGW = F.G * NWAVES;
    int bcur = -1; f32x4 shv[4], scv[4], nwv[4];
    for (int m = 4 * gw; m < M; m += 4 * NGW) {
        const int b = m >> 13;
        if (b != bcur) { bcur = b;
#pragma unroll
            for (int j = 0; j < 4; ++j) { const int c0 = 8 * F.lane + 512 * (j >> 1) + 4 * (j & 1); nwv[j] = *(const f32x4*)(F.norm_w + c0);
#pragma unroll
                for (int k = 0; k < 4; ++k) { const int cidx = c0 + k;
                    shv[j][k] = __hip_atomic_load(F.MOD + b * 3072 + cidx, __ATOMIC_RELAXED, __HIP_MEMORY_SCOPE_AGENT) + F.b_ada[cidx];
                    scv[j][k] = __hip_atomic_load(F.MOD + b * 3072 + 1024 + cidx, __ATOMIC_RELAXED, __HIP_MEMORY_SCOPE_AGENT) + F.b_ada[1024 + cidx] + 1.0f; } } }
        const GAS f32x4* xr = (const GAS f32x4*)(F.x + (size_t)m * D) + 2 * F.lane;
        f32x4 v[4][4]; float sq[4];
#pragma unroll
        for (int r = 0; r < 4; ++r)
#pragma unroll
            for (int j = 0; j < 4; ++j) v[r][j] = __builtin_nontemporal_load(xr + 256 * r + 128 * (j >> 1) + (j & 1));
#pragma unroll
        for (int r = 0; r < 4; ++r) { sq[r] = 0.f;
#pragma unroll
            for (int j = 0; j < 4; ++j) sq[r] += (v[r][j].x * v[r][j].x + v[r][j].y * v[r][j].y) + (v[r][j].z * v[r][j].z + v[r][j].w * v[r][j].w); }
#pragma unroll
        for (int o = 1; o < 64; o <<= 1) {
#pragma unroll
            for (int r = 0; r < 4; ++r) sq[r] += __shfl_xor(sq[r], o); }
        GAS v4u* o16 = (GAS v4u*)(F.XN + (size_t)m * D) + F.lane;
#pragma unroll
        for (int r = 0; r < 4; ++r) { const float rs = 1.f / sqrtf(sq[r] * (1.f / D) + EPS);
#pragma unroll
            for (int jj = 0; jj < 2; ++jj) { const f32x4 h0 = v[r][2 * jj] * rs * nwv[2 * jj] * scv[2 * jj] + shv[2 * jj], h1 = v[r][2 * jj + 1] * rs * nwv[2 * jj + 1] * scv[2 * jj + 1] + shv[2 * jj + 1];
                v4u w; w.x = pk2(h0.x, h0.y); w.y = pk2(h0.z, h0.w); w.z = pk2(h1.x, h1.y); w.w = pk2(h1.z, h1.w);
                o16[128 * r + 64 * jj] = w; } }
    }
}

__device__ __forceinline__ void p5_scan(Frame& F) {
    const int gtid = F.vcu * 512 + F.tid, NT = F.G * 512;
    for (int e = gtid; e < BATCH * SH * 8192 / 2; e += NT) {
        const int bh = e >> 12, pn = (e & 4095) * 2, b = bh >> 5, h = bh & 31;
        float r0 = 0.f, r1 = 0.f;
        for (int c = 0; c < NCH; ++c) {
            const int u = (b * NCH + c) * SH + h;
            GAS unsigned* sp = (GAS unsigned*)(F.ST + (size_t)u * 8192 + pn);
            const unsigned w = *sp; const float dec = F.CDEC[u];
            *sp = pk2(r0, r1);
            r0 = r0 * dec + blo(w); r1 = r1 * dec + bhi(w);
        }
    }
}


typedef float f32x16 __attribute__((ext_vector_type(16)));
typedef short s16x4 __attribute__((ext_vector_type(4)));
typedef short v4i16_t __attribute__((ext_vector_type(4)));
typedef unsigned v2u __attribute__((ext_vector_type(2)));
typedef float f32x2_t __attribute__((ext_vector_type(2))); typedef __bf16 bf16x2_t __attribute__((ext_vector_type(2)));
#define MFMA32(a, b, c) __builtin_amdgcn_mfma_f32_32x32x16_bf16((a), (b), (c), 0, 0, 0)
__device__ __forceinline__ unsigned cvtpk(float lo, float hi) { f32x2_t v = {lo, hi}; bf16x2_t b = __builtin_convertvector(v, bf16x2_t); return __builtin_bit_cast(unsigned, b); }
__device__ __forceinline__ s16x4 trr(LAS const unsigned char* p) { return __builtin_bit_cast(s16x4, __builtin_amdgcn_ds_read_tr16_b64_v4i16((LAS v4i16_t*)p)); }
__device__ __forceinline__ bf16x8 cat4(s16x4 lo, s16x4 hi) { return __builtin_shufflevector(lo, hi, 0, 1, 2, 3, 4, 5, 6, 7); }
__device__ __forceinline__ int crow(int reg, int h) { return (reg & 3) + 8 * (reg >> 2) + 4 * h; }
__device__ __forceinline__ bf16x8 pack_step(const f32x16& x, int s) {
    v4u p; p.x = cvtpk(x[8 * s], x[8 * s + 1]); p.y = cvtpk(x[8 * s + 2], x[8 * s + 3]); p.z = cvtpk(x[8 * s + 4], x[8 * s + 5]); p.w = cvtpk(x[8 * s + 6], x[8 * s + 7]);
    return __builtin_bit_cast(bf16x8, p);
}
__device__ __forceinline__ void unpack8(const v4u w, float* f) { f[0] = blo(w.x); f[1] = bhi(w.x); f[2] = blo(w.y); f[3] = bhi(w.y); f[4] = blo(w.z); f[5] = bhi(w.z); f[6] = blo(w.w); f[7] = bhi(w.w); }

__device__ __forceinline__ void p3_attn(Frame& F) {
    constexpr int KP = 144, VP = 192;
    constexpr float L2E = 1.4426950408889634f;
    LAS unsigned char* Kn = F.lds + RING_OFF;
    LAS unsigned char* Vs = F.lds + RING_OFF + 256 * KP;
    LAS float* tab = (LAS float*)(F.lds + SMALL_OFF);
    LAS unsigned char* Tw = F.lds + RING_OFF + 256 * KP + 256 * VP + F.wave * 4096;
    const int lane = F.lane, r32 = lane & 31, hh = lane >> 5, w = F.wave, g = w >> 1, qh = w & 1;
    const int blk = (lane >> 4) & 1, q4 = (lane & 15) >> 2, p4 = lane & 3;
    if ((F.G & 3) == 0) {
        const int hk0 = F.vcu & 3;
        for (int i = F.tid; i < 4 * 192; i += 512) { const int gg = i / 192, dist = i % 192 - 32;
            tab[i] = (dist >= 0 && dist < 128) ? F.rel_bias[t5_bucket(dist) * NHEAD + hk0 * 4 + gg] * L2E : -INFINITY; }
    }
    v4u qnext[4];
    if (F.vcu < BATCH * (SEQ / 128) * NKV) { const int u0 = F.vcu; const bf16* qg = F.Q + ((size_t)(u0 >> 8) * SEQ + (size_t)((u0 >> 2) & 63) * 128 + 64 * qh + (lane >> 3)) * D + ((u0 & 3) * 4 + g) * HD + (lane & 7) * 8;
#pragma unroll
        for (int i = 0; i < 4; ++i) qnext[i] = *(const GAS v4u*)(qg + (size_t)(8 * i) * D); }
    for (int u = F.vcu; u < BATCH * (SEQ / 128) * NKV; u += F.G) {
        const int hk = u & 3, nb = (u >> 2) & 63, b = u >> 8;
        const size_t tok0 = (size_t)b * SEQ + (size_t)nb * 128;
        if ((F.G & 3) != 0) { for (int i = F.tid; i < 4 * 192; i += 512) { const int gg = i / 192, dist = i % 192 - 32;
            tab[i] = (dist >= 0 && dist < 128) ? F.rel_bias[t5_bucket(dist) * NHEAD + hk * 4 + gg] * L2E : -INFINITY; } }
        const int head = hk * 4 + g;
        {
            const int key = F.tid >> 1, half = F.tid & 1;
            const bool valid = (nb > 0) || (key >= 128);
            const size_t krow = valid ? (tok0 + key - 128) : tok0;
            const bf16* kp = F.KB + krow * 256 + hk * HD + half * 32;
            const bf16* vp = F.VB + krow * 256 + hk * HD + half * 32;
            v4u kw[4], vw[4];
#pragma unroll
            for (int i = 0; i < 4; ++i) { kw[i] = *(const GAS v4u*)(kp + 8 * i); vw[i] = *(const GAS v4u*)(vp + 8 * i); }
            if (!valid) {
#pragma unroll
                for (int i = 0; i < 4; ++i) { kw[i] = (v4u){0u, 0u, 0u, 0u}; vw[i] = (v4u){0u, 0u, 0u, 0u}; } }
            float kf[32]; float ss = 0.f;
#pragma unroll
            for (int i = 0; i < 4; ++i) unpack8(kw[i], kf + 8 * i);
#pragma unroll
            for (int i = 0; i < 32; ++i) ss += kf[i] * kf[i];
            ss += __shfl_xor(ss, 1);
            const float rs = 1.f / sqrtf(ss * (1.f / 64.f) + EPS);
#pragma unroll
            for (int i = 0; i < 4; ++i) { const f32x4 w0 = *(const f32x4*)(F.k_norm_w + half * 32 + 8 * i), w1 = *(const f32x4*)(F.k_norm_w + half * 32 + 8 * i + 4);
                v4u o; o.x = cvtpk(kf[8 * i] * rs * w0[0], kf[8 * i + 1] * rs * w0[1]); o.y = cvtpk(kf[8 * i + 2] * rs * w0[2], kf[8 * i + 3] * rs * w0[3]);
                o.z = cvtpk(kf[8 * i + 4] * rs * w1[0], kf[8 * i + 5] * rs * w1[1]); o.w = cvtpk(kf[8 * i + 6] * rs * w1[2], kf[8 * i + 7] * rs * w1[3]);
                *(LAS v4u*)(Kn + key * KP + half * 64 + 16 * i) = o;
                *(LAS v4u*)(Vs + key * VP + half * 64 + 16 * i) = vw[i]; }
        }
        __syncthreads();
        const float sinkl = F.sinks[head] * L2E;
        const bool first = (nb == 0);
#pragma unroll 1
        for (int sb = 0; sb < 2; ++sb) {
            const int qi0 = 64 * qh + 32 * sb, kt0 = qi0 >> 5;
            bf16x8 qf[4];
            {
#pragma unroll
                for (int i = 0; i < 4; ++i) { const int r = 8 * i + (lane >> 3); *(LAS v4u*)(Tw + r * 128 + (((lane & 7) ^ ((r >> 1) & 7)) << 4)) = qnext[i]; }
                {
                    const int un = sb == 0 ? u : u + F.G;
                    if (un < BATCH * (SEQ / 128) * NKV) { const bf16* qg = F.Q + ((size_t)(un >> 8) * SEQ + (size_t)((un >> 2) & 63) * 128 + 64 * qh + (sb == 0 ? 32 : 0) + (lane >> 3)) * D + ((un & 3) * 4 + g) * HD + (lane & 7) * 8;
#pragma unroll
                        for (int i = 0; i < 4; ++i) qnext[i] = *(const GAS v4u*)(qg + (size_t)(8 * i) * D); }
                }
                v4u qr[4]; float qv[32]; float ss = 0.f;
#pragma unroll
                for (int ks = 0; ks < 4; ++ks) { qr[ks] = *(const LAS v4u*)(Tw + r32 * 128 + (((2 * ks + hh) ^ ((r32 >> 1) & 7)) << 4)); unpack8(qr[ks], qv + 8 * ks); }
#pragma unroll
                for (int i = 0; i < 32; ++i) ss += qv[i] * qv[i];
                ss += __shfl_xor(ss, 32);
                const float qs = 0.125f * L2E / sqrtf(ss * (1.f / 64.f) + EPS);
#pragma unroll
                for (int ks = 0; ks < 4; ++ks) { const f32x4 w0 = *(const f32x4*)(F.q_norm_w + 16 * ks + 8 * hh), w1 = *(const f32x4*)(F.q_norm_w + 16 * ks + 8 * hh + 4);
                    v4u o; o.x = cvtpk(qv[8 * ks] * qs * w0[0], qv[8 * ks + 1] * qs * w0[1]); o.y = cvtpk(qv[8 * ks + 2] * qs * w0[2], qv[8 * ks + 3] * qs * w0[3]);
                    o.z = cvtpk(qv[8 * ks + 4] * qs * w1[0], qv[8 * ks + 5] * qs * w1[1]); o.w = cvtpk(qv[8 * ks + 6] * qs * w1[2], qv[8 * ks + 7] * qs * w1[3]);
                    qf[ks] = __builtin_bit_cast(bf16x8, o); }
            }
            v4u zr4[4];
#pragma unroll
            for (int i = 0; i < 4; ++i) zr4[i] = *(const GAS v4u*)(F.ZA + (tok0 + qi0 + (lane >> 3) + 8 * i) * D + head * HD + (lane & 7) * 8);
            f32x16 X[5];
#pragma unroll
            for (int t = 0; t < 5; ++t) {
#pragma unroll
                for (int i = 0; i < 16; ++i) X[t][i] = tab[g * 192 + r32 + 160 - 32 * t - crow(i, hh)];
                const LAS unsigned char* kb = Kn + (32 * (kt0 + t) + r32) * KP + 16 * hh;
#pragma unroll
                for (int ks = 0; ks < 4; ++ks) { const bf16x8 a = *(const LAS bf16x8*)(kb + 32 * ks); X[t] = MFMA32(a, qf[ks], X[t]); }
            }
            if (first) {
#pragma unroll
                for (int t = 0; t < 5; ++t) if (kt0 + t < 4) {
#pragma unroll
                    for (int i = 0; i < 16; ++i) X[t][i] = -INFINITY; }
            }
            float mx = sinkl;
#pragma unroll
            for (int t = 0; t < 5; ++t)
#pragma unroll
                for (int i = 0; i < 16; ++i) mx = fmaxf(mx, X[t][i]);
            mx = fmaxf(mx, __shfl_xor(mx, 32));
            float sum = 0.f;
#pragma unroll
            for (int t = 0; t < 5; ++t)
#pragma unroll
                for (int i = 0; i < 16; ++i) { const float p = __builtin_amdgcn_exp2f(X[t][i] - mx); X[t][i] = p; sum += p; }
            sum += __shfl_xor(sum, 32);
            sum += __builtin_amdgcn_exp2f(sinkl - mx);
            f32x16 O[2];
#pragma unroll
            for (int i = 0; i < 16; ++i) { O[0][i] = 0.f; O[1][i] = 0.f; }
#pragma unroll
            for (int t = 0; t < 5; ++t)
#pragma unroll
                for (int s = 0; s < 2; ++s) { const bf16x8 pk = pack_step(X[t], s);
                    const LAS unsigned char* vb = Vs + (32 * (kt0 + t) + 16 * s + 4 * hh + q4) * VP + 32 * blk + 8 * p4;
#pragma unroll
                    for (int dt = 0; dt < 2; ++dt) { const bf16x8 a = cat4(trr(vb + 64 * dt), trr(vb + 8 * VP + 64 * dt)); O[dt] = MFMA32(a, pk, O[dt]); } }
            const float inv = 1.f / sum;
            {
#pragma unroll
                for (int i = 0; i < 4; ++i) { const int r = 8 * i + (lane >> 3); *(LAS v4u*)(Tw + r * 128 + (((lane & 7) ^ ((r >> 1) & 7)) << 4)) = zr4[i]; }
                LAS unsigned char* tr = Tw + r32 * 128 + 8 * hh; const int sw = (r32 >> 1) & 7;
#pragma unroll
                for (int dt = 0; dt < 2; ++dt)
#pragma unroll
                    for (int qd = 0; qd < 4; ++qd) { LAS v2u* pz = (LAS v2u*)(tr + (((4 * dt + qd) ^ sw) << 4)); const v2u z = *pz; v2u o;
                        o.x = cvtpk(O[dt][4 * qd] * inv * blo(z.x), O[dt][4 * qd + 1] * inv * bhi(z.x)); o.y = cvtpk(O[dt][4 * qd + 2] * inv * blo(z.y), O[dt][4 * qd + 3] * inv * bhi(z.y));
                        *pz = o; }
                bf16* og = F.Q + (tok0 + qi0 + (lane >> 3)) * D + head * HD + (lane & 7) * 8;
#pragma unroll
                for (int i = 0; i < 4; ++i) { const int r = 8 * i + (lane >> 3); const v4u v = *(const LAS v4u*)(Tw + r * 128 + (((lane & 7) ^ ((r >> 1) & 7)) << 4)); *(GAS v4u*)(og + (size_t)(8 * i) * D) = v; }
            }
        }
        __syncthreads();
    }
}

__device__ __forceinline__ void conv8_load(const bf16* XBC, size_t rowb, int t, int gc, v4u (&raw)[7], const bf16* pre, bool prev_ok) {
#pragma unroll
    for (int i = 0; i < 7; ++i) { const int tt = t - 3 + i;
        raw[i] = (v4u){0u, 0u, 0u, 0u};
        if (i < 3) { if (prev_ok) raw[i] = *(const GAS v4u*)(pre ? pre + i * 2048 : XBC + (rowb + tt) * XBCW + gc); }
        else raw[i] = *(const GAS v4u*)(XBC + (rowb + tt) * XBCW + gc); }
}
__device__ __forceinline__ void conv8_apply(const float* cw, const float* cb, int gc, const v4u (&raw)[7], float (&o)[4][8]) {
    float w[4][8];
#pragma unroll
    for (int j = 0; j < 4; ++j) { const f32x4 a = *(const f32x4*)(cw + j * XBCW + gc), c = *(const f32x4*)(cw + j * XBCW + gc + 4);
        w[j][0] = a[0]; w[j][1] = a[1]; w[j][2] = a[2]; w[j][3] = a[3]; w[j][4] = c[0]; w[j][5] = c[1]; w[j][6] = c[2]; w[j][7] = c[3]; }
    { const f32x4 a = *(const f32x4*)(cb + gc), c = *(const f32x4*)(cb + gc + 4);
#pragma unroll
      for (int r = 0; r < 4; ++r) { o[r][0] = a[0]; o[r][1] = a[1]; o[r][2] = a[2]; o[r][3] = a[3]; o[r][4] = c[0]; o[r][5] = c[1]; o[r][6] = c[2]; o[r][7] = c[3]; } }
#pragma unroll
    for (int i = 0; i < 7; ++i) { float x[8]; unpack8(raw[i], x);
#pragma unroll
        for (int r = 0; r < 4; ++r) { const int j = i - r;
            if (j >= 0 && j < 4) {
#pragma unroll
                for (int k = 0; k < 8; ++k) o[r][k] += w[j][k] * x[k]; } } }
#pragma unroll
    for (int r = 0; r < 4; ++r)
#pragma unroll
        for (int k = 0; k < 8; ++k) o[r][k] = o[r][k] * __builtin_amdgcn_rcpf(1.f + __builtin_amdgcn_exp2f(-1.4426950408889634f * o[r][k]));
}
__device__ __forceinline__ v4u pack8(const float* f, float s) { v4u o; o.x = cvtpk(f[0] * s, f[1] * s); o.y = cvtpk(f[2] * s, f[3] * s); o.z = cvtpk(f[4] * s, f[5] * s); o.w = cvtpk(f[6] * s, f[7] * s); return o; }

__device__ __forceinline__ void chunk_cumsum(const float* DT, size_t row0, int hd, float a, int lane, float& d0, float& d1, float& ac0, float& ac1, float& aend) {
    { const f32x2_t dd = *(const GAS f32x2_t*)(DT + ((row0 >> 7) * 32 + hd) * 128 + 2 * lane); d0 = dd[0]; d1 = dd[1]; }
    const float v1 = d1 * a; float s = d0 * a + v1;
#pragma unroll
    for (int o = 1; o < 64; o <<= 1) { const float t = __shfl_up(s, o); if (lane >= o) s += t; }
    aend = __shfl(s, 63); ac1 = s; ac0 = s - v1;
}

__device__ __forceinline__ void p4_states(Frame& F) {
    constexpr int XP = 576, BP = 320;
    LAS unsigned char* Xw = F.lds + RING_OFF;
    LAS unsigned char* Bs = F.lds + RING_OFF + 128 * XP;
    LAS float* sW = (LAS float*)(F.lds + SMALL_OFF);
    const int lane = F.lane, r32 = lane & 31, hh = lane >> 5, w = F.wave, hl = w >> 1, nh = w & 1;
    const int blk = (lane >> 4) & 1, q4 = (lane & 15) >> 2, p4 = lane & 3;
    v4u raw[3][7];
#define P4_ISSUE(un) do { const int hq_ = (un) & 1, g_ = ((un) >> 1) & 3, c_ = ((un) >> 3) & 63, b_ = (un) >> 9; const size_t rowb_ = (size_t)b_ * SEQ; \
        _Pragma("unroll") for (int k_ = 0; k_ < 3; ++k_) { const int it_ = F.tid + 512 * k_, ch_ = it_ % 48, rg_ = it_ / 48, l0_ = rg_ * 4; \
            if (ch_ < 32) { const int gc_ = (g_ * 8 + hq_ * 4) * 64 + ch_ * 8; const bool first_ = (rg_ == 0); \
                conv8_load(F.XBC, rowb_, c_ * CH + l0_, gc_, raw[k_], first_ ? F.HALO + ((size_t)(b_ * NCH + c_ - 1) * 3) * 2048 + gc_ : nullptr, !first_ || c_ > 0); } \
            else { const int gc_ = SSMW + g_ * SN + (ch_ - 32) * 8; conv8_load(F.XBC, rowb_, c_ * CH + l0_, gc_, raw[k_], nullptr, c_ * CH + l0_ > 0); } } } while (0)
    if (F.vcu < BATCH * NCH * SG * 2) P4_ISSUE(F.vcu);
    for (int u = F.vcu; u < BATCH * NCH * SG * 2; u += F.G) {
        const int hq = u & 1, g = (u >> 1) & 3, c = (u >> 3) & 63, b = u >> 9;
        const int t0 = c * CH; const size_t rowb = (size_t)b * SEQ, row0 = rowb + t0;
        if (w < 4) { const int hd = g * 8 + hq * 4 + w; float d0, d1, ac0, ac1, aend; int ln = lane; asm volatile("" : "+v"(ln));
            chunk_cumsum(F.DT, row0, hd, -__expf(F.a_log[hd]), ln, d0, d1, ac0, ac1, aend);
            sW[w * 128 + 2 * ln] = d0 * __expf(aend - ac0); sW[w * 128 + 2 * ln + 1] = d1 * __expf(aend - ac1);
            if (ln == 63) F.CDEC[(b * NCH + c) * SH + hd] = __expf(aend); }
#pragma unroll
        for (int itk = 0; itk < 3; ++itk) { const int it = F.tid + 512 * itk;
            const int ch = it % 48, rg = it / 48, l0 = rg * 4;
            float o[4][8];
            if (ch < 32) {
                conv8_apply(F.conv_w, F.conv_b, (g * 8 + hq * 4) * 64 + ch * 8, raw[itk], o);
#pragma unroll
                for (int r = 0; r < 4; ++r) *(LAS v4u*)(Xw + (l0 + r) * XP + ch * 16) = pack8(o[r], 1.f);
            } else {
                conv8_apply(F.conv_w, F.conv_b, SSMW + g * SN + (ch - 32) * 8, raw[itk], o);
#pragma unroll
                for (int r = 0; r < 4; ++r) *(LAS v4u*)(Bs + (l0 + r) * BP + (ch - 32) * 16) = pack8(o[r], 1.f);
            }
        }
        __syncthreads();
        if (u + F.G < BATCH * NCH * SG * 2) P4_ISSUE(u + F.G);
        f32x16 acc[2][2];
#pragma unroll
        for (int i = 0; i < 16; ++i) { acc[0][0][i] = 0.f; acc[0][1][i] = 0.f; acc[1][0][i] = 0.f; acc[1][1][i] = 0.f; }
        const LAS unsigned char* ab = Bs + (8 * hh + q4) * BP + 128 * nh + 32 * blk + 8 * p4;
        const LAS unsigned char* bb = Xw + (8 * hh + q4) * XP + 128 * hl + 32 * blk + 8 * p4;
        bf16* xt = F.XBC + (row0 + (size_t)(hl * 32 + hh)) * XBCW + g * 512 + hq * 256 + r32 * 8;
#pragma unroll 2
        for (int ks = 0; ks < 8; ++ks) {
            bf16x8 A[2], B[2];
#pragma unroll
            for (int nt = 0; nt < 2; ++nt) A[nt] = cat4(trr(ab + 16 * ks * BP + 64 * nt), trr(ab + (16 * ks + 4) * BP + 64 * nt));
#pragma unroll
            for (int pt = 0; pt < 2; ++pt) B[pt] = cat4(trr(bb + 16 * ks * XP + 64 * pt), trr(bb + (16 * ks + 4) * XP + 64 * pt));
            {
                const f32x4 w0 = *(const LAS f32x4*)(sW + hl * 128 + 16 * ks + 8 * hh), w1 = *(const LAS f32x4*)(sW + hl * 128 + 16 * ks + 8 * hh + 4);
#pragma unroll
                for (int nt = 0; nt < 2; ++nt) { const v4u a = __builtin_bit_cast(v4u, A[nt]); v4u o;
                    o.x = cvtpk(blo(a.x) * w0[0], bhi(a.x) * w0[1]); o.y = cvtpk(blo(a.y) * w0[2], bhi(a.y) * w0[3]); o.z = cvtpk(blo(a.z) * w1[0], bhi(a.z) * w1[1]); o.w = cvtpk(blo(a.w) * w1[2], bhi(a.w) * w1[3]);
                    A[nt] = __builtin_bit_cast(bf16x8, o); }
            }
            if (nh == 0) {
#pragma unroll
                for (int pt = 0; pt < 2; ++pt) *(GAS v4u*)(xt + (size_t)((ks * 2 + pt) * 2) * XBCW) = __builtin_bit_cast(v4u, B[pt]);
            }
#pragma unroll
            for (int nt = 0; nt < 2; ++nt)
#pragma unroll
                for (int pt = 0; pt < 2; ++pt) acc[nt][pt] = MFMA32(A[nt], B[pt], acc[nt][pt]);
        }
        {
            const int hd = g * 8 + hq * 4 + hl;
            bf16* sp = F.ST + (size_t)((b * NCH + c) * SH + hd) * 8192;
#pragma unroll
            for (int nt = 0; nt < 2; ++nt)
#pragma unroll
                for (int pt = 0; pt < 2; ++pt)
#pragma unroll
                    for (int qd = 0; qd < 4; ++qd) { v2u o; o.x = cvtpk(acc[nt][pt][4 * qd], acc[nt][pt][4 * qd + 1]); o.y = cvtpk(acc[nt][pt][4 * qd + 2], acc[nt][pt][4 * qd + 3]);
                        *(GAS v2u*)(sp + (((2 * (2 * nh + nt) + (qd >> 1)) * 2 + pt) * 64 + (qd & 1) * 32 + r32) * 8 + 4 * hh) = o; }
        }
        __syncthreads();
    }
#undef P4_ISSUE
}

__device__ __forceinline__ void p6_scan(Frame& F) {
    constexpr int CP = 272;
    LAS unsigned char* Cs = F.lds + RING_OFF;
    LAS unsigned char* Bs = F.lds + RING_OFF + 128 * CP;
    LAS float* sDT = (LAS float*)(F.lds + SMALL_OFF);
    LAS float* sAC = sDT + 1024;
    LAS float* ssq = sDT + 2048;
    LAS float* sES = ssq;
    const int lane = F.lane, r32 = lane & 31, hh = lane >> 5, w = F.wave;
    for (int u = F.vcu; u < BATCH * NCH * SG; u += F.G) {
        const int g = u & 3, c = (u >> 2) & 63, b = u >> 8;
        const int t0 = c * CH; const size_t rowb = (size_t)b * SEQ, row0 = rowb + t0;
        const int hd = g * 8 + w;
        { float d0, d1, ac0, ac1, aend; int ln = lane; asm volatile("" : "+v"(ln));
          chunk_cumsum(F.DT, row0, hd, -__expf(F.a_log[hd]), ln, d0, d1, ac0, ac1, aend);
          sDT[w * 128 + 2 * ln] = d0; sDT[w * 128 + 2 * ln + 1] = d1; sAC[w * 128 + 2 * ln] = ac0; sAC[w * 128 + 2 * ln + 1] = ac1;
          const float et = __shfl(ac1, 16 * (ln >> 4) + 15);
          sES[w * 128 + 2 * ln] = d0 * __expf(et - ac0); sES[w * 128 + 2 * ln + 1] = d1 * __expf(et - ac1); }
        {
            v4u raw[2][7];
#pragma unroll
            for (int it2 = 0; it2 < 2; ++it2) { const int it = F.tid + 512 * it2, ch = it & 31, l0 = (it >> 5) * 4;
                conv8_load(F.XBC, rowb, t0 + l0, SSMW + (ch < 16 ? 0 : SG * SN) + g * SN + (ch & 15) * 8, raw[it2], nullptr, t0 + l0 > 0); }
#pragma unroll
            for (int it2 = 0; it2 < 2; ++it2) { const int it = F.tid + 512 * it2, ch = it & 31, l0 = (it >> 5) * 4;
                float o[4][8];
                conv8_apply(F.conv_w, F.conv_b, SSMW + (ch < 16 ? 0 : SG * SN) + g * SN + (ch & 15) * 8, raw[it2], o);
                LAS unsigned char* dst = (ch < 16 ? Bs : Cs) + l0 * CP + (ch & 15) * 16;
#pragma unroll
                for (int r = 0; r < 4; ++r) *(LAS v4u*)(dst + r * CP) = pack8(o[r], 1.f);
                asm volatile("" ::: "memory"); }
        }
        bf16x8 HA[8][2];
        { int ln2 = lane; asm volatile("" : "+v"(ln2));
          const bf16* hp = F.ST + (size_t)((b * NCH + c) * SH + hd) * 8192 + ln2 * 8;
#pragma unroll
          for (int ks = 0; ks < 8; ++ks)
#pragma unroll
              for (int pt = 0; pt < 2; ++pt) HA[ks][pt] = __builtin_bit_cast(bf16x8, *(const GAS v4u*)(hp + (ks * 2 + pt) * 512)); }
        __syncthreads();
        f32x16 yacc[4][2];
#pragma unroll
        for (int lt = 0; lt < 4; ++lt)
#pragma unroll
            for (int i = 0; i < 16; ++i) { yacc[lt][0][i] = 0.f; yacc[lt][1][i] = 0.f; }
        {
            const LAS unsigned char* cb = Cs + r32 * CP + 16 * hh;
#pragma unroll
            for (int ks = 0; ks < 8; ++ks) {
                bf16x8 Bf[4];
#pragma unroll
                for (int lt = 0; lt < 4; ++lt) Bf[lt] = *(const LAS bf16x8*)(cb + 32 * lt * CP + 32 * ks);
#pragma unroll
                for (int lt = 0; lt < 4; ++lt)
#pragma unroll
                    for (int pt = 0; pt < 2; ++pt) yacc[lt][pt] = MFMA32(HA[ks][pt], Bf[lt], yacc[lt][pt]);
                if (ks & 1) asm volatile("" ::: "memory");
            }
#pragma unroll
            for (int lt = 0; lt < 4; ++lt) { const float e = __expf(sAC[w * 128 + 32 * lt + r32]);
#pragma unroll
                for (int i = 0; i < 16; ++i) { yacc[lt][0][i] *= e; yacc[lt][1][i] *= e; } }
        }
        const float dsk = F.d_skip[hd];
        const bf16* xt = F.XBC + (row0 + (size_t)((w & 3) * 32)) * XBCW + g * 512 + (w >> 2) * 256 + r32 * 8 + 4 * hh;
#pragma unroll 1
        for (int st = 0; st < 4; ++st) {
            v2u xr[2][2][2];
#pragma unroll
            for (int s = 0; s < 2; ++s)
#pragma unroll
                for (int pt = 0; pt < 2; ++pt)
#pragma unroll
                    for (int hf = 0; hf < 2; ++hf) xr[s][pt][hf] = *(const GAS v2u*)(xt + (size_t)(((2 * st + s) * 2 + pt) * 2 + hf) * XBCW);
            const LAS unsigned char* ab = Bs + (32 * st + r32) * CP + 16 * hh;
#pragma unroll
            for (int lt = 0; lt < 4; ++lt) {
                if (lt >= st) {
                    f32x16 X;
#pragma unroll
                    for (int i = 0; i < 16; ++i) X[i] = 0.f;
                    const LAS unsigned char* cb = Cs + (32 * lt + r32) * CP + 16 * hh; const float acl_lt = sAC[w * 128 + 32 * lt + r32];
#pragma unroll 2
                    for (int ks = 0; ks < 8; ++ks) X = MFMA32(*(const LAS bf16x8*)(ab + 32 * ks), *(const LAS bf16x8*)(cb + 32 * ks), X);
                    if (lt == st) {
#pragma unroll
                        for (int qd = 0; qd < 4; ++qd) { const int sl0 = 8 * qd + 4 * hh;
                            const f32x4 av = *(const LAS f32x4*)(sAC + w * 128 + 32 * st + sl0), dv = *(const LAS f32x4*)(sDT + w * 128 + 32 * st + sl0);
#pragma unroll
                            for (int k = 0; k < 4; ++k) { float f = __expf(acl_lt - av[k]) * dv[k];
                                if (sl0 + k > r32) f = 0.f;
                                float v = X[4 * qd + k] * f;
                                if (sl0 + k == r32) v += dsk;
                                X[4 * qd + k] = v; }
                            asm volatile("" ::: "memory"); }
                    } else {
                        const float cl = __expf(acl_lt - sAC[w * 128 + 32 * st + 31]);
#pragma unroll
                        for (int qd = 0; qd < 4; ++qd) { const f32x4 ev = *(const LAS f32x4*)(sES + w * 128 + 32 * st + 8 * qd + 4 * hh);
#pragma unroll
                            for (int k = 0; k < 4; ++k) X[4 * qd + k] *= cl * ev[k]; }
                    }
#pragma unroll
                    for (int s = 0; s < 2; ++s) { const bf16x8 xp = pack_step(X, s);
#pragma unroll
                        for (int pt = 0; pt < 2; ++pt) { const v4u xa = (v4u){xr[s][pt][0].x, xr[s][pt][0].y, xr[s][pt][1].x, xr[s][pt][1].y};
                            yacc[lt][pt] = MFMA32(__builtin_bit_cast(bf16x8, xa), xp, yacc[lt][pt]); } }
                }
            }
        }
        LAS unsigned char* Yw = F.lds + RING_OFF + w * 16384;
        {
            int ln4 = lane; asm volatile("" : "+v"(ln4));
            const bf16* zg = F.ZM + (size_t)(hd >> 4) * M * 1024 + (row0 + (ln4 >> 3)) * 1024 + (hd & 15) * 64 + (ln4 & 7) * 8;
            v4u zr[8];
#pragma unroll
            for (int i = 0; i < 8; ++i) zr[i] = *(const GAS v4u*)(zg + (size_t)(8 * i) * 1024);
            __syncthreads();
#pragma unroll 1
            for (int hb = 0; hb < 2; ++hb) {
#pragma unroll
                for (int i = 0; i < 8; ++i) { const int t = 8 * (8 * hb + i) + (lane >> 3); *(LAS v4u*)(Yw + t * 128 + (((lane & 7) ^ ((t >> 1) & 7)) << 4)) = zr[i]; }
                if (hb == 0) {
#pragma unroll
                    for (int i = 0; i < 8; ++i) zr[i] = *(const GAS v4u*)(zg + (size_t)(8 * (8 + i)) * 1024); }
                asm volatile("" ::: "memory"); }
        }
        float ss[4];
#pragma unroll
        for (int lt = 0; lt < 4; ++lt) { ss[lt] = 0.f; const int t = 32 * lt + r32; const LAS unsigned char* yr = Yw + t * 128 + 8 * hh; const int sw = (t >> 1) & 7;
#pragma unroll
            for (int pt = 0; pt < 2; ++pt)
#pragma unroll
                for (int qd = 0; qd < 4; ++qd) { const v2u z = *(const LAS v2u*)(yr + (((4 * pt + qd) ^ sw) << 4));
                    const float y0 = yacc[lt][pt][4 * qd] * blo(z.x), y1 = yacc[lt][pt][4 * qd + 1] * bhi(z.x), y2 = yacc[lt][pt][4 * qd + 2] * blo(z.y), y3 = yacc[lt][pt][4 * qd + 3] * bhi(z.y);
                    yacc[lt][pt][4 * qd] = y0; yacc[lt][pt][4 * qd + 1] = y1; yacc[lt][pt][4 * qd + 2] = y2; yacc[lt][pt][4 * qd + 3] = y3;
                    ss[lt] += (y0 * y0 + y1 * y1) + (y2 * y2 + y3 * y3); }
            ss[lt] += __shfl_xor(ss[lt], 32);
            if (hh == 0) ssq[w * 128 + t] = ss[lt];
            asm volatile("" ::: "memory"); }
        __syncthreads();
#pragma unroll
        for (int lt = 0; lt < 4; ++lt) { float tot = 0.f; const int t = 32 * lt + r32;
#pragma unroll
            for (int k = 0; k < 8; ++k) tot += ssq[k * 128 + t];
            const float rs = 1.f / sqrtf(tot * (1.f / 512.f) + EPS);
            LAS unsigned char* yr = Yw + t * 128 + 8 * hh; const int sw = (t >> 1) & 7; const float* nw = F.ssm_norm_w + hd * 64 + 4 * hh;
#pragma unroll
            for (int pt = 0; pt < 2; ++pt)
#pragma unroll
                for (int qd = 0; qd < 4; ++qd) { const f32x4 wv = *(const f32x4*)(nw + 32 * pt + 8 * qd); v2u o;
                    o.x = cvtpk(yacc[lt][pt][4 * qd] * rs * wv[0], yacc[lt][pt][4 * qd + 1] * rs * wv[1]); o.y = cvtpk(yacc[lt][pt][4 * qd + 2] * rs * wv[2], yacc[lt][pt][4 * qd + 3] * rs * wv[3]);
                    *(LAS v2u*)(yr + (((4 * pt + qd) ^ sw) << 4)) = o; }
            asm volatile("" ::: "memory"); }
        {
            int ln3 = lane; asm volatile("" : "+v"(ln3));
            bf16* zg = F.ZM + (size_t)(hd >> 4) * M * 1024 + (row0 + (ln3 >> 3)) * 1024 + (hd & 15) * 64 + (ln3 & 7) * 8;
#pragma unroll 4
            for (int i = 0; i < 16; ++i) { const int t = 8 * i + (lane >> 3); const v4u v = *(const LAS v4u*)(Yw + t * 128 + (((lane & 7) ^ ((t >> 1) & 7)) << 4)); *(GAS v4u*)(zg + (size_t)(8 * i) * 1024) = v; if ((i & 3) == 3) asm volatile("" ::: "memory"); }
        }
        __syncthreads();
    }
}

struct Args { const float* in[19]; float* out; unsigned char* ws; int ph_lo, ph_hi, li, pad; };
__global__ void __launch_bounds__(NWAVES * 64, 2) mk_fwd(Args args) {
    extern __shared__ __attribute__((aligned(16))) unsigned char lds[];
    Frame F;
    F.lds = (LAS unsigned char*)lds;
    F.MISC = (volatile LAS unsigned*)(F.lds + MISC_OFF);
    F.tid = threadIdx.x; F.lane = F.tid & 63; F.wave = __builtin_amdgcn_readfirstlane(F.tid >> 6);
    F.G = gridDim.x; { const int bx = blockIdx.x; F.vcu = (F.G % 8 == 0) ? (bx % 8) * (F.G / 8) + bx / 8 : bx; }
    unsigned char* ws = args.ws;
    F.ctl = (gu32*)(ws + WS_CTL);
    F.x = args.in[0]; F.c = args.in[1]; F.w_ada = args.in[2]; F.b_ada = args.in[3]; F.norm_w = args.in[4]; F.w_in = args.in[5]; F.q_norm_w = args.in[6]; F.k_norm_w = args.in[7];
    F.rel_bias = args.in[8]; F.sinks = args.in[9]; F.conv_w = args.in[10]; F.conv_b = args.in[11]; F.dt_bias = args.in[12]; F.a_log = args.in[13]; F.d_skip = args.in[14];
    F.ssm_norm_w = args.in[15]; F.w_attn = args.in[16]; F.w_ssm = args.in[17]; F.w_out = args.in[18]; F.out = args.out;
    F.WIN = (bf16*)(ws + WS_WIN); F.WA = (bf16*)(ws + WS_WA); F.WS = (bf16*)(ws + WS_WS); F.WO = (bf16*)(ws + WS_WO);
    F.XN = (bf16*)(ws + WS_XN); F.Q = (bf16*)(ws + WS_Q); F.ZM = (bf16*)(ws + WS_ZM); F.XBC = (bf16*)(ws + WS_XBC);
    F.HALO = (bf16*)(ws + WS_HALO); F.GA = (bf16*)(ws + WS_GA); F.GB = (bf16*)(ws + WS_GB); F.MG = (bf16*)(ws + WS_MG);
    F.KB = (bf16*)((unsigned char*)args.out + OUT_K); F.VB = (bf16*)((unsigned char*)args.out + OUT_V); F.ZA = (bf16*)((unsigned char*)args.out + OUT_ZA); F.ST = (bf16*)((unsigned char*)args.out + OUT_ST);
    F.MOD = (float*)(ws + WS_MISC); F.CDEC = (float*)(ws + WS_MISC + 32768); F.DT = (float*)(ws + WS_DT);
    for (int u = F.tid; u < (LDS_BYTES - LDSCTL_OFF) / 4; u += NWAVES * 64) ((LAS unsigned*)(F.lds + LDSCTL_OFF))[u] = 0u;
    __syncthreads();
    XcdBarrier bar; bar.bar = (unsigned*)(F.ctl + CW_BAR); bar.x = 0; bar.st = nullptr;
    if (N_LAUNCHES != PER_PHASE) bar = xcd_barrier_post((unsigned*)(F.ctl + CW_BAR), F.MISC + 8);
#define GRID_BAR() do { if (N_LAUNCHES != PER_PHASE) xcd_barrier(bar); } while (0)
    const int lo = args.ph_lo, hi = args.ph_hi;
#define IN(k) (lo <= (k) && (k) < hi)
#define BOTH(k) (IN(k) && IN((k) + 1))


#define PH0() do { if (IN(0)) { p0_prologue(F); } } while (0)
#define PH1() do { if (IN(1)) { p0_wait_mod(F); p1_norm(F); if (BOTH(1)) GRID_BAR(); } } while (0)
#define PH2() do { if (IN(2)) { \
        pg8::Gemm g{F.XN, F.WIN, M, N_MAIN, D}; pg8::StaticOrder S; S.init(M, N_MAIN, F.G, (int)blockIdx.x); \
        pg8::EpiInProj E{F.Q, F.KB, F.VB, F.ZA, F.ZM, F.XBC, F.GA, F.GB, F.DT, F.dt_bias, 0, F.HALO}; \
        pg8::gemm_phase<pg8::EpiInProj, pg8::StaticOrder, PG8_ALIGN, PG8_SP2>(F.lds + RING_OFF, g, S, E); \
        { const int nfull = (M / 256) * (N_MAIN / 256) % (int)F.G;     \
          if ((int)blockIdx.x >= nfull) p0_late(F, nfull); } \
        if (BOTH(2)) GRID_BAR(); } } while (0)
#define PH3() do { if (IN(3)) { p3_attn(F); if (BOTH(3)) GRID_BAR(); } } while (0)
#define PH4() do { if (IN(4)) { p4_states(F); if (BOTH(4)) GRID_BAR(); } } while (0)
#define PH5() do { if (IN(5)) { p5_scan(F); if (BOTH(5)) GRID_BAR(); } } while (0)
#define PH6() do { if (IN(6)) { p6_scan(F); if (BOTH(6)) GRID_BAR(); } } while (0)
#ifndef PAIR_BARRIER
#define PAIR_BARRIER 0
#endif
#define PH7() do { if (IN(7)) { \
        pg8::Gemm g{F.XN, F.WIN + (size_t)N_MAIN * D, M, N_GATE, D}; pg8::PairOrder S; S.base.init(M, D, F.G, (int)blockIdx.x); \
        pg8::EpiInProj E{F.Q, F.KB, F.VB, F.ZA, F.ZM, F.XBC, F.GA, F.GB, F.DT, F.dt_bias, 31, F.HALO}; \
        pg8::gemm_phase<pg8::EpiInProj, pg8::PairOrder, PG8_ALIGN, PG8_SP2>(F.lds + RING_OFF, g, S, E); \
        if (PAIR_BARRIER && BOTH(7)) GRID_BAR(); } } while (0)
#define PH8() do { if (IN(8)) { \
        { pg8::Gemm g{F.Q, F.WA, M, D, D}; pg8::StaticOrder S; S.init(M, D, F.G, (int)blockIdx.x); \
          pg8::EpiGate<0> E{F.GA, F.MG}; \
          pg8::gemm_phase<pg8::EpiGate<0>, pg8::StaticOrder, PG8_ALIGN, PG8_SP2>(F.lds + RING_OFF, g, S, E); } \
        { pg8::Gemm g{F.ZM, F.WS, M, D, D}; pg8::ChainOrder S; S.base.init(M, D, F.G, (int)blockIdx.x); S.ZM = F.ZM; S.WS = F.WS; \
          pg8::EpiGate<1> E{F.GB, F.MG}; \
          pg8::gemm_phase<pg8::EpiGate<1>, pg8::ChainOrder, PG8_ALIGN, PG8_SP2>(F.lds + RING_OFF, g, S, E); } \
        if (BOTH(8)) GRID_BAR(); } } while (0)
#define PH9(LAST) do { if (IN(9)) { \
        pg8::Gemm g{F.MG, F.WO, M, D, D}; pg8::StaticOrder S; S.init(M, D, F.G, (int)blockIdx.x); \
        pg8::EpiOut E{F.x, F.MOD + 2048, F.b_ada + 2048, F.out}; \
        pg8::gemm_phase<pg8::EpiOut, pg8::StaticOrder, PG8_ALIGN, PG8_SP2>(F.lds + RING_OFF, g, S, E); \
        if (!(LAST)) GRID_BAR(); } } while (0)
#ifndef REP
#define REP 0
#endif
#ifdef TPROBE
    unsigned long long tp0 = 0, tp1 = 0;
#define TP(k, X) do { if ((k) == TPROBE) tp0 = rt(); X; if ((k) == TPROBE) tp1 = rt(); } while (0)
#else
#define TP(k, X) do { X; } while (0)
#endif
    TP(0, PH0()); TP(1, PH1()); TP(2, PH2()); TP(3, PH3()); TP(4, PH4()); TP(5, PH5()); TP(6, PH6()); TP(7, PH7()); TP(8, PH8()); TP(9, PH9(true));
#ifdef TPROBE
    if (blockIdx.x == 0) { const unsigned long long need = (tp1 - tp0) * 8ull, s0 = rt(); while (rt() - s0 < need) __builtin_amdgcn_s_sleep(20); }
#endif
#undef IN
#undef BOTH
}

extern "C" void kernel_launch(void* const* d_in, const int* in_sizes, int n_in, void* d_out, int out_size, void* d_ws, size_t ws_size, hipStream_t stream) {
    static int grid = 0;
    if (grid == 0) {
        if (n_in != 19 || in_sizes[0] != M * D || out_size != M * D || ws_size < WS_END) { fprintf(stderr, "kernel_launch: unexpected shapes (n_in %d, in0 %d, out %d, ws %zu); nothing launched\n", n_in, n_in > 0 ? in_sizes[0] : -1, out_size, ws_size); grid = -1; return; }
        int dev = 0, cus = 0, per_cu = 0;
        if (hipGetDevice(&dev) != hipSuccess || hipDeviceGetAttribute(&cus, hipDeviceAttributeMultiprocessorCount, dev) != hipSuccess) { grid = -1; return; }
        if (hipFuncSetAttribute((const void*)mk_fwd, hipFuncAttributeMaxDynamicSharedMemorySize, LDS_BYTES) != hipSuccess) { fprintf(stderr, "kernel_launch: hipFuncSetAttribute failed\n"); grid = -1; return; }
        if (hipOccupancyMaxActiveBlocksPerMultiprocessor(&per_cu, (const void*)mk_fwd, NWAVES * 64, LDS_BYTES) != hipSuccess || per_cu < 1) { fprintf(stderr, "kernel_launch: occupancy query says %d blocks/CU\n", per_cu); }
        (void)hipGetLastError();
        grid = cus;
    }
    if (grid < 0) return;
    (void)hipMemsetAsync((char*)d_ws + WS_CTL, 0, CTL_ZERO_BYTES, stream);
    (void)hipMemsetAsync((char*)d_ws + WS_MISC, 0, 2 * 3072 * sizeof(float), stream);
    Args a{};
    for (int i = 0; i < 19; ++i) a.in[i] = (const float*)d_in[i];
    a.out = (float*)d_out; a.ws = (unsigned char*)d_ws;
    for (int li = 0; li < N_LAUNCHES; ++li) {
        a.ph_lo = (N_LAUNCHES == PER_PHASE) ? li : 0; a.ph_hi = (N_LAUNCHES == PER_PHASE) ? li + 1 : PER_PHASE; a.li = li;
        hipLaunchKernelGGL(mk_fwd, dim3(grid), dim3(NWAVES * 64), LDS_BYTES, stream, a);
    }
}
```

```cpp
#include <hip/hip_runtime.h>
#include <cstdio>
#include <cstdint>
#include <cmath>
namespace pg8 {
#define PG8_LAS __attribute__((address_space(3)))
typedef unsigned short bf16_t;
typedef short bf16x8 __attribute__((ext_vector_type(8)));
typedef float f32x4 __attribute__((ext_vector_type(4)));
typedef unsigned u32x4 __attribute__((ext_vector_type(4)));
constexpr int BM = 256, BK = 64, HALF = 128, HTB = HALF * BK * 2  , STAGE_BYTES = 8 * HTB, NXCD = 8, WGM = 8;

__host__ __device__ __forceinline__ int lds_byte(int r, int c) { const int st = (r >> 4) * 2 + (c >> 5), rr = r & 15, cc = c & 31, ob = rr * 64 + cc * 2; return st * 1024 + (ob ^ (((ob >> 9) & 1) << 5)); }
__host__ __device__ __forceinline__ void stage_rc(int b, int& R, int& C) { const int st = b / 1024, sb = b % 1024, swz = sb ^ (((sb >> 9) & 1) << 5); R = (st >> 1) * 16 + swz / 64; C = (st & 1) * 32 + (swz % 64) / 2; }
__host__ __device__ __forceinline__ int perm32(int rho) { const int n = rho >> 4, i = rho & 15; return 8 * (i >> 2) + 4 * n + (i & 3); }

struct Unit { int pm, pn; const bf16_t* A = nullptr; const bf16_t* B = nullptr; int mode = 0; int chain = 0; };
struct Gemm { const bf16_t* A; const bf16_t* Bt; int M, N, K; };

struct StaticOrder {
    int nM, nN, nwg, G, c;
    __host__ __device__ void init(int M, int N, int G_, int c_) { nM = M / BM; nN = N / BM; nwg = nM * nN; G = G_; c = c_; }
    __host__ __device__ bool next(int i, Unit& u) const {
        const long L = (long)i * G + c; if (L >= nwg) return false;
        int wgid = (int)L; { const int q = nwg / NXCD, r = nwg % NXCD, xcd = wgid % NXCD, off = wgid / NXCD; wgid = (xcd < r ? xcd * (q + 1) : r * (q + 1) + (xcd - r) * q) + off; }
        const int nig = WGM * nN, gid = wgid / nig, fm = gid * WGM, gsz = (nM - fm) < WGM ? (nM - fm) : WGM;
        u.pm = fm + ((wgid % nig) % gsz); u.pn = (wgid % nig) / gsz; return true;
    }
    __device__ __forceinline__ void a_ready(const Unit&) const {}
    __device__ __forceinline__ void done(const Unit&) const {}
};

__device__ __forceinline__ unsigned cvt_pk_bf16(float lo, float hi) { unsigned r; asm volatile("v_cvt_pk_bf16_f32 %0, %1, %2" : "=v"(r) : "v"(lo), "v"(hi)); return r; }
__device__ __forceinline__ float sigm(float v) { return __builtin_amdgcn_rcpf(1.f + __builtin_amdgcn_exp2f(-1.4426950408889634f * v)); }
__device__ __forceinline__ float bflo(unsigned w) { return __uint_as_float(w << 16); }
__device__ __forceinline__ float bfhi(unsigned w) { return __uint_as_float(w & 0xffff0000u); }

__device__ __forceinline__ float softplus_f(float x) {
    const float e = __builtin_amdgcn_exp2f(-1.4426950408889634f * __builtin_fabsf(x));
    const float ser = e * (1.f + e * (-0.5f + e * (0.33333334f - 0.25f * e)));
    const float lg = 0.6931471805599453f * __builtin_amdgcn_logf(1.f + e);
    return __builtin_fmaxf(x, 0.f) + (e < 0.015625f ? ser : lg);
}

struct EpiInProj {
    static constexpr bool PERM = true, AFTER_DRAIN = false;
    bf16_t *Q, *Kb, *Vb, *ZA, *ZM, *XBC, *GA, *GB; float* DT; const float* dt_bias; int tile_off; bf16_t* HALO;
    __device__ __forceinline__ void operator()(const f32x4 (&acc)[2][2][4][2], const Unit& u, int wr, int wc, int fr, int fq) const {
        const int pn = u.pn + tile_off;
        const int row0 = u.pm * BM + wr * 64 + fr;
        if (pn == 30) {
            if (wc == 0) {
                const int c = 8 * fq;
                const f32x4 b0 = *(const f32x4*)(dt_bias + c), b1 = *(const f32x4*)(dt_bias + c + 4);
#pragma unroll
                for (int ai = 0; ai < 2; ++ai)
#pragma unroll
                    for (int m = 0; m < 4; ++m) {
                        const int r = row0 + ai * HALF + m * 16;
                        float* rp = DT + ((size_t)(r >> 7) * 32 + c) * 128 + (r & 127);
                        f32x4 v0 = acc[ai][0][m][0] + b0, v1 = acc[ai][0][m][1] + b1;
#pragma unroll
                        for (int j = 0; j < 4; ++j) { v0[j] = softplus_f(v0[j]); v1[j] = softplus_f(v1[j]); }
#pragma unroll
                        for (int j = 0; j < 4; ++j) { rp[j * 128] = v0[j]; rp[(4 + j) * 128] = v1[j]; }
                    }
            }
            return;
        }
        bf16_t* base; int ldc, c0, act;
        if (pn < 4) { base = Q; ldc = 1024; c0 = pn * 256; act = 0; }
        else if (pn == 4) { base = Kb; ldc = 256; c0 = 0; act = 0; }
        else if (pn == 5) { base = Vb; ldc = 256; c0 = 0; act = 0; }
        else if (pn < 10) { base = ZA; ldc = 1024; c0 = (pn - 6) * 256; act = 1; }
        else if (pn < 18) { base = ZM + (pn >= 14 ? (size_t)16384 * 1024 : 0); ldc = 1024; c0 = ((pn - 10) & 3) * 256; act = 1; }
        else if (pn < 30) { base = XBC; ldc = 3072; c0 = (pn - 18) * 256; act = 0; }
        else if (pn < 35) { base = GA; ldc = 1024; c0 = (pn - 31) * 256; act = 2; }
        else { base = GB; ldc = 1024; c0 = (pn - 35) * 256; act = 2; }
        const int col0 = c0 + wc * 32 + 8 * fq;
#pragma unroll
        for (int ai = 0; ai < 2; ++ai)
#pragma unroll
            for (int m = 0; m < 4; ++m) { bf16_t* rowp = base + (size_t)(row0 + ai * HALF + m * 16) * ldc + col0;
#pragma unroll
                for (int bj = 0; bj < 2; ++bj) { f32x4 v0 = acc[ai][bj][m][0], v1 = acc[ai][bj][m][1];
                    if (act == 1) {
#pragma unroll
                        for (int j = 0; j < 4; ++j) { v0[j] = v0[j] * sigm(v0[j]); v1[j] = v1[j] * sigm(v1[j]); } }
                    else if (act == 2) {
#pragma unroll
                        for (int j = 0; j < 4; ++j) { v0[j] = sigm(v0[j]); v1[j] = sigm(v1[j]); } }
                    u32x4 w; w.x = cvt_pk_bf16(v0[0], v0[1]); w.y = cvt_pk_bf16(v0[2], v0[3]); w.z = cvt_pk_bf16(v1[0], v1[1]); w.w = cvt_pk_bf16(v1[2], v1[3]);
                    *(u32x4*)(rowp + bj * HALF) = w;
                    if (pn >= 18 && pn < 26 && wr == 1 && m == 3 && fr >= 13) {
                        const int r = row0 + ai * HALF + m * 16;
                        *(u32x4*)(HALO + ((size_t)(r >> 7) * 3 + (fr - 13)) * 2048 + col0 + bj * HALF) = w; } } }
    }
};

template <int MODE> struct EpiGate {
    static constexpr bool PERM = true, AFTER_DRAIN = false;
    const bf16_t* G; bf16_t* O;
    __device__ __forceinline__ void operator()(const f32x4 (&acc)[2][2][4][2], const Unit& u, int wr, int wc, int fr, int fq) const {
        const int row0 = u.pm * BM + wr * 64 + fr, col0 = u.pn * BM + wc * 32 + 8 * fq;
#pragma unroll
        for (int ai = 0; ai < 2; ++ai)
#pragma unroll
            for (int m = 0; m < 4; ++m) { const size_t off = (size_t)(row0 + ai * HALF + m * 16) * 1024 + col0;
#pragma unroll
                for (int bj = 0; bj < 2; ++bj) { const f32x4 v0 = acc[ai][bj][m][0], v1 = acc[ai][bj][m][1];
                    const u32x4 g = *(const u32x4*)(G + off + bj * HALF);
                    float r[8];
                    r[0] = bflo(g.x) * v0[0]; r[1] = bfhi(g.x) * v0[1]; r[2] = bflo(g.y) * v0[2]; r[3] = bfhi(g.y) * v0[3];
                    r[4] = bflo(g.z) * v1[0]; r[5] = bfhi(g.z) * v1[1]; r[6] = bflo(g.w) * v1[2]; r[7] = bfhi(g.w) * v1[3];
                    if (MODE == 1) { const u32x4 o = *(const u32x4*)(O + off + bj * HALF);
                        r[0] += bflo(o.x); r[1] += bfhi(o.x); r[2] += bflo(o.y); r[3] += bfhi(o.y); r[4] += bflo(o.z); r[5] += bfhi(o.z); r[6] += bflo(o.w); r[7] += bfhi(o.w); }
                    u32x4 w; w.x = cvt_pk_bf16(r[0], r[1]); w.y = cvt_pk_bf16(r[2], r[3]); w.z = cvt_pk_bf16(r[4], r[5]); w.w = cvt_pk_bf16(r[6], r[7]);
                    *(u32x4*)(O + off + bj * HALF) = w; } }
    }
};

struct EpiOut {
    static constexpr bool PERM = false, AFTER_DRAIN = false;
    const float* x; const float* gate; const float* gbias; float* out;
    __device__ __forceinline__ void operator()(const f32x4 (&acc)[2][2][4][2], const Unit& u, int wr, int wc, int fr, int fq) const {
        const int row0 = u.pm * BM + wr * 64 + fr, col0 = u.pn * BM + wc * 32 + 4 * fq;
        const float* gb = gate + (size_t)((u.pm * BM) >> 13) * 3072;
#pragma unroll
        for (int bj = 0; bj < 2; ++bj)
#pragma unroll
            for (int n = 0; n < 2; ++n) { const int c = col0 + bj * HALF + n * 16; f32x4 gv = *(const f32x4*)(gbias + c);
#pragma unroll
                for (int k = 0; k < 4; ++k) gv[k] += __hip_atomic_load(gb + c + k, __ATOMIC_RELAXED, __HIP_MEMORY_SCOPE_AGENT);
#pragma unroll
                for (int ai = 0; ai < 2; ++ai)
#pragma unroll
                    for (int m = 0; m < 4; ++m) { const size_t off = (size_t)(row0 + ai * HALF + m * 16) * 1024 + c;
                        const f32x4 xv = *(const f32x4*)(x + off); *(f32x4*)(out + off) = xv + gv * acc[ai][bj][m][n]; } }
    }
};


struct ChainOrder {
    StaticOrder base; const bf16_t *ZM, *WS;
    __device__ bool next(int i, Unit& u) const {
        if (i >= 2) return false;
        if (!base.next(0, u)) return false;
        if (i == 0) { u.A = ZM; u.B = WS; u.mode = 3; u.chain = 1; }
        else { u.A = ZM + (size_t)16384 * 1024; u.B = WS + (size_t)1024 * 1024; u.mode = 4; u.chain = 0; }
        return true;
    }
    __device__ __forceinline__ void a_ready(const Unit&) const {}
    __device__ __forceinline__ void done(const Unit&) const {}
};

struct PairOrder {
    StaticOrder base;
    __device__ bool next(int i, Unit& u) const { if (i >= 2) return false; if (!base.next(0, u)) return false; u.pn += 4 * i; return true; }
    __device__ __forceinline__ void a_ready(const Unit&) const {}
    __device__ __forceinline__ void done(const Unit&) const {}
};
template <class Epi, class Sched, bool ALIGN_EPI = false, bool SP2 = false>
__device__ __forceinline__ void gemm_phase(PG8_LAS unsigned char* lds, const Gemm g, const Sched& S, const Epi& E) {
    const int tid = threadIdx.x, wid = __builtin_amdgcn_readfirstlane(tid >> 6), lane = tid & 63, wr = wid >> 2, wc = wid & 3, fr = lane & 15, fq = lane >> 4;
    const int K = g.K, nt = K / BK;
    unsigned voffA[2], voffB[2];
#pragma unroll
    for (int i = 0; i < 2; ++i) { int R, C; stage_rc(tid * 16 + i * 8192, R, C); const int Rb = Epi::PERM ? ((R & ~31) + perm32(R & 31)) : R;
        voffA[i] = (unsigned)(R * K + C) * 2u; voffB[i] = (unsigned)(Rb * K + C) * 2u; }
    const size_t kstep = (size_t)(BK * 2);
    const size_t hstep = (size_t)HALF * K * 2;
    const size_t tstep = 2 * hstep;
    const unsigned ldsw = (unsigned)wid * 1024u;
    const int aoff = lds_byte(wr * 64 + fr, fq * 8), boff = lds_byte(wc * 32 + fr, fq * 8);
#define PG8_SA(b, h) (((b) * 2 + (h)) * HTB)
#define PG8_SB(b, h) ((4 + (b) * 2 + (h)) * HTB)
#define PG8_STAGE(bufoff, gbase, voff) do { _Pragma("unroll") for (int _i = 0; _i < 2; ++_i) \
        __builtin_amdgcn_global_load_lds((const unsigned*)((const char*)(gbase) + (voff)[_i]), (PG8_LAS unsigned*)(lds + (bufoff) + ldsw + _i * 8192), 16, 0, 0); } while (0)
#define PG8_LDA(dst, b, h) do { _Pragma("unroll") for (int m = 0; m < 4; ++m) _Pragma("unroll") for (int k = 0; k < 2; ++k) dst[m][k] = *(const PG8_LAS bf16x8*)(lds + PG8_SA(b, h) + aoff + m * 2048 + k * 1024); } while (0)
#define PG8_LDB(dst, b, h) do { _Pragma("unroll") for (int n = 0; n < 2; ++n) _Pragma("unroll") for (int k = 0; k < 2; ++k) dst[n][k] = *(const PG8_LAS bf16x8*)(lds + PG8_SB(b, h) + boff + n * 2048 + k * 1024); } while (0)
#define PG8_MMA(ai, bj, At, Bt) do { __builtin_amdgcn_s_setprio(1); _Pragma("unroll") for (int m = 0; m < 4; ++m) _Pragma("unroll") for (int n = 0; n < 2; ++n) _Pragma("unroll") for (int k = 0; k < 2; ++k) \
        acc[ai][bj][m][n] = __builtin_amdgcn_mfma_f32_16x16x32_bf16(Bt[n][k], At[m][k], acc[ai][bj][m][n], 0, 0, 0); __builtin_amdgcn_s_setprio(0); } while (0)
#define PG8_WAIT_V(n) asm volatile("s_waitcnt vmcnt(" #n ")" ::: "memory")
#define PG8_WAIT_L(n) asm volatile("s_waitcnt lgkmcnt(" #n ")" ::: "memory")
#define PG8_BAR do { __builtin_amdgcn_s_barrier(); asm volatile("" ::: "memory"); } while (0)
#define PG8_SCHED __builtin_amdgcn_sched_barrier(0)
    Unit cur, nxt; int ui = 0;
    if (!S.next(0, cur)) return;
    f32x4 acc[2][2][4][2];
#pragma unroll
    for (int a = 0; a < 2; ++a)
#pragma unroll
        for (int b = 0; b < 2; ++b)
#pragma unroll
            for (int m = 0; m < 4; ++m)
#pragma unroll
                for (int n = 0; n < 2; ++n) acc[a][b][m][n] = (f32x4){0.f, 0.f, 0.f, 0.f};
    bf16x8 At[4][2], B0[2][2], B1[2][2];
    const char* cA = (const char*)(cur.A ? cur.A : g.A) + (size_t)cur.pm * tstep; const char* cB = (const char*)(cur.B ? cur.B : g.Bt) + (size_t)cur.pn * tstep;
    S.a_ready(cur);
    if constexpr (SP2) {
        PG8_STAGE(PG8_SB(0, 0), cB, voffB); PG8_STAGE(PG8_SB(0, 1), cB + hstep, voffB); PG8_STAGE(PG8_SA(0, 0), cA, voffA); PG8_STAGE(PG8_SA(0, 1), cA + hstep, voffA);
        if (wr == 1) PG8_BAR;
        PG8_WAIT_V(2); PG8_BAR;
        PG8_STAGE(PG8_SB(1, 0), cB + kstep, voffB); PG8_STAGE(PG8_SA(1, 0), cA + kstep, voffA); PG8_STAGE(PG8_SB(1, 1), cB + hstep + kstep, voffB);
        PG8_WAIT_V(6); PG8_BAR;
    } else {
        PG8_STAGE(PG8_SB(0, 0), cB, voffB); PG8_STAGE(PG8_SA(0, 0), cA, voffA); PG8_STAGE(PG8_SB(0, 1), cB + hstep, voffB); PG8_STAGE(PG8_SA(0, 1), cA + hstep, voffA);
        if (wr == 1) PG8_BAR;
        PG8_WAIT_V(4); PG8_BAR;
        PG8_STAGE(PG8_SB(1, 0), cB + kstep, voffB); PG8_STAGE(PG8_SA(1, 0), cA + kstep, voffA); PG8_STAGE(PG8_SB(1, 1), cB + hstep + kstep, voffB);
        PG8_WAIT_V(6); PG8_BAR;
    }
    for (;;) {
        const bool has_next = S.next(ui + 1, nxt);
        const char* nA = has_next ? (const char*)(nxt.A ? nxt.A : g.A) + (size_t)nxt.pm * tstep : cA; const char* nB = has_next ? (const char*)(nxt.B ? nxt.B : g.Bt) + (size_t)nxt.pn * tstep : cB;
        for (int t = 0; t < nt; t += 2) {
            const bool last = (t == nt - 2);
            const char* a1 = cA + (size_t)(t + 1) * kstep;
            const char* a2 = last ? nA : cA + (size_t)(t + 2) * kstep; const char* b2 = last ? nB : cB + (size_t)(t + 2) * kstep;
            const char* a3 = a2 + kstep; const char* b3 = b2 + kstep;
            if (last && has_next) S.a_ready(nxt);
            if constexpr (SP2) {
            PG8_LDB(B0, 0, 0); PG8_LDB(B1, 0, 1); PG8_SCHED; PG8_LDA(At, 0, 0); PG8_STAGE(PG8_SA(1, 1), a1 + hstep, voffA);
            PG8_WAIT_V(8); PG8_WAIT_L(0); PG8_BAR; PG8_MMA(0, 0, At, B0); PG8_MMA(0, 1, At, B1); PG8_BAR; PG8_SCHED;
            PG8_LDA(At, 0, 1); PG8_STAGE(PG8_SB(0, 0), b2, voffB); PG8_STAGE(PG8_SB(0, 1), b2 + hstep, voffB); PG8_STAGE(PG8_SA(0, 0), a2, voffA);
            PG8_WAIT_V(8); PG8_WAIT_L(0); PG8_BAR; PG8_MMA(1, 0, At, B0); PG8_MMA(1, 1, At, B1); PG8_BAR; PG8_SCHED;
            PG8_LDB(B0, 1, 0); PG8_LDB(B1, 1, 1); PG8_SCHED; PG8_LDA(At, 1, 0); PG8_STAGE(PG8_SA(0, 1), a2 + hstep, voffA);
            PG8_WAIT_V(8); PG8_WAIT_L(0); PG8_BAR; PG8_MMA(0, 0, At, B0); PG8_MMA(0, 1, At, B1); PG8_BAR; PG8_SCHED;
            PG8_LDA(At, 1, 1); PG8_STAGE(PG8_SB(1, 0), b3, voffB); PG8_STAGE(PG8_SB(1, 1), b3 + hstep, voffB); PG8_STAGE(PG8_SA(1, 0), a3, voffA);
            PG8_WAIT_V(8); PG8_WAIT_L(0); PG8_BAR; PG8_MMA(1, 0, At, B0); PG8_MMA(1, 1, At, B1); PG8_BAR; PG8_SCHED;
            } else {
            PG8_LDB(B0, 0, 0); PG8_SCHED; PG8_LDA(At, 0, 0); PG8_STAGE(PG8_SA(1, 1), a1 + hstep, voffA);
            PG8_WAIT_L(8); PG8_BAR; PG8_WAIT_L(0); PG8_MMA(0, 0, At, B0); PG8_BAR; PG8_SCHED;
            PG8_LDB(B1, 0, 1); PG8_STAGE(PG8_SB(0, 0), b2, voffB);
            PG8_BAR; PG8_WAIT_L(0); PG8_MMA(0, 1, At, B1); PG8_BAR;
            PG8_LDA(At, 0, 1); PG8_STAGE(PG8_SA(0, 0), a2, voffA);
            PG8_BAR; PG8_WAIT_L(0); PG8_MMA(1, 0, At, B0); PG8_BAR; PG8_SCHED;
            PG8_STAGE(PG8_SB(0, 1), b2 + hstep, voffB);
            PG8_WAIT_V(6); PG8_BAR; PG8_MMA(1, 1, At, B1); PG8_BAR;
            PG8_LDB(B0, 1, 0); PG8_SCHED; PG8_LDA(At, 1, 0); PG8_STAGE(PG8_SA(0, 1), a2 + hstep, voffA);
            PG8_WAIT_L(8); PG8_BAR; PG8_WAIT_L(0); PG8_MMA(0, 0, At, B0); PG8_BAR; PG8_SCHED;
            PG8_LDB(B1, 1, 1); PG8_STAGE(PG8_SB(1, 0), b3, voffB);
            PG8_BAR; PG8_WAIT_L(0); PG8_MMA(0, 1, At, B1); PG8_BAR;
            PG8_LDA(At, 1, 1); PG8_STAGE(PG8_SA(1, 0), a3, voffA);
            PG8_BAR; PG8_WAIT_L(0); PG8_MMA(1, 0, At, B0); PG8_BAR; PG8_SCHED;
            PG8_STAGE(PG8_SB(1, 1), b3 + hstep, voffB);
            PG8_WAIT_V(6); PG8_BAR; PG8_MMA(1, 1, At, B1); PG8_BAR;
            }
        }
        if constexpr (ALIGN_EPI) { if (wr == 0) PG8_BAR; }
        if constexpr (!Epi::AFTER_DRAIN) { if (!cur.chain) E(acc, cur, wr, wc, fr, fq); S.done(cur); }
        if (!has_next) break;
        if (!cur.chain)
#pragma unroll
        for (int a = 0; a < 2; ++a)
#pragma unroll
            for (int b = 0; b < 2; ++b)
#pragma unroll
                for (int m = 0; m < 4; ++m)
#pragma unroll
                    for (int n = 0; n < 2; ++n) acc[a][b][m][n] = (f32x4){0.f, 0.f, 0.f, 0.f};
        cur = nxt; cA = nA; cB = nB; ++ui;
        if constexpr (ALIGN_EPI) { if (wr == 1) PG8_BAR; }
    }
    PG8_WAIT_V(0);
    if constexpr (!ALIGN_EPI) { if (wr == 0) PG8_BAR; }
    PG8_BAR;
    if constexpr (Epi::AFTER_DRAIN) { E.fused(acc, cur, wr, wc, fr, fq, lds, wid, lane); S.done(cur); }
#undef PG8_SA
#undef PG8_SB
#undef PG8_STAGE
#undef PG8_LDA
#undef PG8_LDB
#undef PG8_MMA
#undef PG8_WAIT_V
#undef PG8_WAIT_L
#undef PG8_BAR
#undef PG8_SCHED
}
}

#ifndef PG8_SP2
#define PG8_SP2 true
#endif
#ifndef PG8_ALIGN
#define PG8_ALIGN true
#endif
constexpr int NWAVES = 8;
#ifndef MK_N_LAUNCHES
#define MK_N_LAUNCHES 1
#endif
constexpr int PER_PHASE = 10;
constexpr int N_LAUNCHES = MK_N_LAUNCHES;

constexpr int BATCH = 2, SEQ = 8192, D = 1024, M = BATCH * SEQ;
constexpr int NHEAD = 16, NKV = 4, HD = 64;
constexpr int SSMW = 2048, SH = 32, SG = 4, SR = 8, SP = 64, SN = 128, XBCW = 3072, CH = 128, NCH = SEQ / CH;
constexpr int IN_W = 9760, N_MAIN = 31 * 256, N_GATE = 2048, N_INT = N_MAIN + N_GATE;
constexpr float EPS = 1e-6f;

constexpr size_t MiB = 1u << 20;
constexpr size_t WS_CTL = 0, CTL_ZERO_BYTES = 64 * 1024;
constexpr size_t WS_WIN = 64 * 1024;
constexpr size_t WS_WA = WS_WIN + (size_t)N_INT * D * 2;
constexpr size_t WS_WS = WS_WA + 2 * MiB;
constexpr size_t WS_WO = WS_WS + 4 * MiB;
constexpr size_t WS_MISC = WS_WO + 2 * MiB;
constexpr size_t WS_DT = WS_MISC + 64 * 1024;
constexpr size_t WS_HALO = WS_DT + 2 * MiB;
constexpr size_t WS_XN = 32 * MiB;
constexpr size_t WS_Q = 64 * MiB;
constexpr size_t WS_ZM = 96 * MiB;
constexpr size_t WS_XBC = 160 * MiB;
constexpr size_t WS_GA = 160 * MiB, WS_GB = 192 * MiB, WS_MG = 224 * MiB, WS_END = 256 * MiB;
static_assert(WS_HALO + (size_t)(M / 128) * 3 * 2048 * 2 <= WS_XN, "ws map");
constexpr size_t OUT_K = 0, OUT_V = 8 * MiB, OUT_ZA = 16 * MiB, OUT_ST = 0;

constexpr int CW_MODCNT = 64;
constexpr int CW_BAR = 4096;

constexpr int RING_OFF = 0, RING_BYTES = 131072;
constexpr int LDSCTL_OFF = RING_BYTES, MISC_OFF = LDSCTL_OFF + 320;
constexpr int SMALL_OFF = RING_BYTES + 1024;
constexpr int LDS_BYTES = 147456;

#define GAS __attribute__((address_space(1)))
#define LAS __attribute__((address_space(3)))
typedef unsigned short bf16;
typedef unsigned v4u __attribute__((ext_vector_type(4)));
typedef float f32x4 __attribute__((ext_vector_type(4)));
typedef short bf16x8 __attribute__((ext_vector_type(8)));
typedef GAS unsigned gu32;
typedef GAS unsigned long long gu64;
#define RLX_AGENT __ATOMIC_RELAXED, __HIP_MEMORY_SCOPE_AGENT
#define LDS_WAIT() asm volatile("s_waitcnt lgkmcnt(0)" ::: "memory")
#define VM_WAIT() asm volatile("s_waitcnt vmcnt(0)" ::: "memory")
__device__ __forceinline__ unsigned long long rt() { return __builtin_amdgcn_s_memrealtime(); }
__device__ __forceinline__ unsigned f2bf(float f) { unsigned u = __builtin_bit_cast(unsigned, f); return (u + 0x7fffu + ((u >> 16) & 1u)) >> 16; }
__device__ __forceinline__ unsigned pk2(float lo, float hi) { return f2bf(lo) | (f2bf(hi) << 16); }

#define XB_TMO      128
#define XB_XCNT(j)  (256  + 64 * (j))
#define XB_XSUB(j)  (1280 + 64 * (j))
#define XB_XGEN(j)  (2304 + 64 * (j))
#define XB_TOP      3328
#define XB_TOPGEN   3392
#define XCD_BAR_WORDS 3456
#define XB_SPIN_CAP (1u << 18)

__device__ __forceinline__ unsigned xb_ld(unsigned* p)              { return __hip_atomic_load(p, __ATOMIC_RELAXED, __HIP_MEMORY_SCOPE_AGENT); }
__device__ __forceinline__ unsigned xb_add(unsigned* p, unsigned v) { return __hip_atomic_fetch_add(p, v, __ATOMIC_RELAXED, __HIP_MEMORY_SCOPE_AGENT); }
__device__ __forceinline__ unsigned xb_xcc_id() { return (unsigned)__builtin_amdgcn_s_getreg((3 << 11) | 20) & 0xFu; }
#define XB_SPIN(cond, bar) do { unsigned _sp = 0; while (cond) { __builtin_amdgcn_s_sleep(1); \
    if ((++_sp & 255u) == 0u) { if (xb_ld(&(bar)[XB_TMO])) break; if (_sp > XB_SPIN_CAP) { atomicAdd(&(bar)[XB_TMO], 1u); break; } } } } while (0)

struct XcdBarrier {
    unsigned* bar; unsigned x;
    volatile LAS unsigned* st;
};

__device__ __forceinline__ XcdBarrier xcd_barrier_post(unsigned* bar, volatile LAS unsigned* st) {
    XcdBarrier b; b.bar = bar; b.x = xb_xcc_id(); b.st = st;
    if (threadIdx.x == 0) (void)xb_add(&bar[XB_XCNT(b.x)], 1u);
    return b;
}
__device__ __forceinline__ void xcd_barrier_complete(unsigned* bar, unsigned x, unsigned& nloc, unsigned& nx) {
    const unsigned G = gridDim.x * gridDim.y * gridDim.z;
    unsigned sum, cnt, mine, sp = 0u;
    for (;;) {
        sum = 0u; cnt = 0u; mine = 0u;
#pragma unroll
        for (unsigned j = 0; j < 16; ++j) { const unsigned c = xb_ld(&bar[XB_XCNT(j)]); sum += c; cnt += (c > 0u) ? 1u : 0u; mine = (j == x) ? c : mine; }
        if (sum == G) break;
        __builtin_amdgcn_s_sleep(1);
        if ((++sp & 255u) == 0u) { if (xb_ld(&bar[XB_TMO])) break; if (sp > XB_SPIN_CAP) { atomicAdd(&bar[XB_TMO], 1u); break; } }
    }
    nloc = mine > 0u ? mine : 1u; nx = cnt > 0u ? cnt : 1u;
}

__device__ __forceinline__ void xcd_barrier(const XcdBarrier& b) {
    asm volatile("s_waitcnt vmcnt(0)" ::: "memory");
    __syncthreads();
    if (threadIdx.x == 0) {
        unsigned* bar = b.bar;
        __builtin_amdgcn_s_waitcnt(0);
        unsigned nloc = b.st[0], nx = b.st[1];
        if (nloc == 0u) { xcd_barrier_complete(bar, b.x, nloc, nx); b.st[0] = nloc; b.st[1] = nx; }
        const unsigned old = xb_add(&bar[XB_XSUB(b.x)], 1u);
        const unsigned gen = old / nloc;
        if (old + 1u == (gen + 1u) * nloc) {
            __builtin_amdgcn_fence(__ATOMIC_RELEASE, "agent");
            asm volatile("s_waitcnt vmcnt(0)" ::: "memory");
            const unsigned og = xb_add(&bar[XB_TOP], 1u);
            const unsigned tg = og / nx;
            if (og + 1u == (tg + 1u) * nx) xb_add(&bar[XB_TOPGEN], 1u);
            else XB_SPIN(xb_ld(&bar[XB_TOPGEN]) == tg, bar);
            __builtin_amdgcn_fence(__ATOMIC_ACQUIRE, "agent");
            xb_add(&bar[XB_XGEN(b.x)], 1u);
            asm volatile("s_waitcnt vmcnt(0)" ::: "memory");
        } else {
            XB_SPIN(xb_ld(&bar[XB_XGEN(b.x)]) == gen, bar);
            __builtin_amdgcn_fence(__ATOMIC_ACQUIRE, "agent");
            asm volatile("s_waitcnt vmcnt(0)" ::: "memory");
        }
    }
    __syncthreads();
}

struct Frame {
    LAS unsigned char* lds;
    volatile LAS unsigned* MISC;
    gu32* ctl;
    int tid, lane, wave;
    int vcu, G;
    const float *x, *c, *w_ada, *b_ada, *norm_w, *w_in, *q_norm_w, *k_norm_w, *rel_bias, *sinks, *conv_w, *conv_b, *dt_bias, *a_log, *d_skip, *ssm_norm_w, *w_attn, *w_ssm, *w_out;
    float* out;
    bf16 *WIN, *WA, *WS, *WO, *XN, *Q, *KB, *VB, *ZA, *ZM, *XBC, *GA, *GB, *MG, *ST, *HALO;
    float *MOD, *CDEC, *DT;
};

__device__ __forceinline__ float wave_sum(float v) {
#pragma unroll
    for (int o = 1; o < 64; o <<= 1) v += __shfl_xor(v, o);
    return v;
}
__device__ __forceinline__ float bf2f(bf16 v) { return __uint_as_float((unsigned)v << 16); }
__device__ __forceinline__ float blo(unsigned w) { return __uint_as_float(w << 16); }
__device__ __forceinline__ float bhi(unsigned w) { return __uint_as_float(w & 0xffff0000u); }
__device__ __forceinline__ float silu_f(float v) { return v / (1.f + __expf(-v)); }
__device__ __forceinline__ int t5_bucket(int n) {
    if (n < 16) return n;
    const int l = 16 + (int)(log2f((float)n * 0.0625f) * (16.0f / 3.0f));
    return l < 31 ? l : 31;
}

typedef short s16x4_ __attribute__((ext_vector_type(4)));
struct P0Item { const float* W; int K, N, row_off, Kd; bf16* WT; int item; };
__device__ __forceinline__ void p0_item_load(const P0Item& it, int lane, f32x4 (&v)[8]) {
    const int nblk = it.N / 32, kb = it.item / nblk, nb = it.item % nblk, k0 = 64 * kb, n0 = 32 * nb;
    const float* src = it.W + (size_t)(k0 + (lane >> 3)) * it.N + n0 + 4 * (lane & 7);
#pragma unroll
    for (int i = 0; i < 8; ++i) v[i] = __builtin_nontemporal_load((const GAS f32x4*)(src + (size_t)(8 * i) * it.N));
}
__device__ __forceinline__ void p0_item_finish(const P0Item& it, int lane, const f32x4 (&v)[8], LAS unsigned char* scr) {
    const int nblk = it.N / 32, kb = it.item / nblk, nb = it.item % nblk, k0 = 64 * kb, n0 = 32 * nb;
#pragma unroll
    for (int i = 0; i < 8; ++i) { unsigned long long w = (unsigned long long)pk2(v[i].x, v[i].y) | ((unsigned long long)pk2(v[i].z, v[i].w) << 32);
        *(LAS unsigned long long*)(scr + (8 * i + (lane >> 3)) * 192 + 8 * (lane & 7)) = w; }
    LDS_WAIT(); asm volatile("" ::: "memory");
    const int h = lane >> 5, blk = (lane >> 4) & 1, q = (lane & 15) >> 2, p = lane & 3;
    const LAS unsigned char* tb = scr + (8 * h + q) * 192 + 32 * blk + 8 * p;
    const int kd = it.Kd ? it.Kd : it.K;
    bf16* dst = it.WT + (size_t)(k0 / kd) * it.N * kd + (size_t)(it.row_off + n0 + (lane & 31)) * kd + (k0 % kd) + 8 * h;
#pragma unroll
    for (int ks = 0; ks < 4; ++ks) {
        const s16x4_ lo = __builtin_bit_cast(s16x4_, __builtin_amdgcn_ds_read_tr16_b64_v4i16((LAS s16x4_*)(tb + 16 * ks * 192)));
        const s16x4_ hi = __builtin_bit_cast(s16x4_, __builtin_amdgcn_ds_read_tr16_b64_v4i16((LAS s16x4_*)(tb + (16 * ks + 4) * 192)));
        const bf16x8 o = __builtin_shufflevector(lo, hi, 0, 1, 2, 3, 4, 5, 6, 7);
        *(GAS bf16x8*)(dst + 16 * ks) = o; }
    LDS_WAIT(); asm volatile("" ::: "memory");
}

__device__ __forceinline__ void p0_prologue(Frame& F) {
    LAS unsigned char* scr = F.lds + RING_OFF + F.wave * 12288;
    const int gw = F.vcu * NWAVES + F.wave, NGW = F.G * NWAVES;
    if (F.vcu < 96) {
        const int cg = F.vcu % 12, n = cg * 256 + 4 * F.lane, k0 = (F.vcu / 12) * 128 + 16 * F.wave;
        f32x4 wv[16];
#pragma unroll
        for (int i = 0; i < 16; ++i) wv[i] = __builtin_nontemporal_load((const GAS f32x4*)(F.w_ada + (size_t)(k0 + i) * 3072 + n));
        f32x4 a0 = {0.f, 0.f, 0.f, 0.f}, a1 = {0.f, 0.f, 0.f, 0.f};
#pragma unroll
        for (int i = 0; i < 16; ++i) { const float c0 = silu_f(F.c[k0 + i]), c1 = silu_f(F.c[1024 + k0 + i]); a0 += wv[i] * c0; a1 += wv[i] * c1; }
        LAS f32x4* part = (LAS f32x4*)(F.lds + RING_OFF + 8 * 12288);
        part[(F.wave * 2 + 0) * 64 + F.lane] = a0; part[(F.wave * 2 + 1) * 64 + F.lane] = a1;
        __syncthreads();
        { const int bb = F.tid >> 8, col = F.tid & 255; float sum = 0.f;
          const LAS float* pf = (const LAS float*)part;
#pragma unroll
          for (int w8 = 0; w8 < 8; ++w8) sum += pf[((w8 * 2 + bb) * 64) * 4 + col];
          atomicAdd(F.MOD + bb * 3072 + cg * 256 + col, sum); }
        asm volatile("s_waitcnt vmcnt(0)" ::: "memory");
        __syncthreads();
        if (F.tid == 0) __hip_atomic_fetch_add(F.ctl + CW_MODCNT, 1u, __ATOMIC_RELAXED, __HIP_MEMORY_SCOPE_AGENT);
    }
    {
        GAS v4u* z = (GAS v4u*)(F.WIN + (size_t)7712 * D); const int n16 = 224 * D * 2 / 16;
        for (int i = F.vcu * 512 + F.tid; i < n16; i += F.G * 512) z[i] = (v4u){0u, 0u, 0u, 0u};
    }
    constexpr int I_IN = (D / 64) * (IN_W / 32), I_A = (D / 64) * (D / 32), I_S = (SSMW / 64) * (D / 32), I_O = I_A;
    constexpr int NITEMS = I_IN + I_A + I_S + I_O;
#define P0_DESC(it_, d_) do { int r_ = (it_); \
        if (r_ < I_IN) { d_ = P0Item{F.w_in, D, IN_W, (r_ % (IN_W / 32)) >= 241 ? 224 : 0, 0, F.WIN, r_}; } \
        else if ((r_ -= I_IN) < I_A) { d_ = P0Item{F.w_attn, D, D, 0, 0, F.WA, r_}; } \
        else if ((r_ -= I_A) < I_S) { d_ = P0Item{F.w_ssm, SSMW, D, 0, D, F.WS, r_}; } \
        else { r_ -= I_S; d_ = P0Item{F.w_out, D, D, 0, 0, F.WO, r_}; } } while (0)
    const int gwt = ((F.vcu + F.G - 96) % F.G) * NWAVES + F.wave;
    for (int it = gwt; it < I_IN; it += 2 * NGW) {
        P0Item da, db; f32x4 va[8], vb[8];
        P0_DESC(it, da); p0_item_load(da, F.lane, va);
        const bool two = it + NGW < I_IN;
        if (two) { P0_DESC(it + NGW, db); p0_item_load(db, F.lane, vb); }
        p0_item_finish(da, F.lane, va, scr);
        if (two) p0_item_finish(db, F.lane, vb, scr);
    }
}
__device__ __forceinline__ void p0_late(Frame& F, int first_wg) {
    LAS unsigned char* scr = F.lds + RING_OFF + F.wave * 12288;
    constexpr int I_IN = (D / 64) * (IN_W / 32), I_A = (D / 64) * (D / 32), I_S = (SSMW / 64) * (D / 32), I_O = I_A;
    constexpr int NITEMS = I_IN + I_A + I_S + I_O;
    const int nw = (F.G - first_wg) * NWAVES, gw = ((int)blockIdx.x - first_wg) * NWAVES + F.wave;
    for (int it = I_IN + gw; it < NITEMS; it += 2 * nw) {
        P0Item da, db; f32x4 va[8], vb[8];
        P0_DESC(it, da); p0_item_load(da, F.lane, va);
        const bool two = it + nw < NITEMS;
        if (two) { P0_DESC(it + nw, db); p0_item_load(db, F.lane, vb); }
        p0_item_finish(da, F.lane, va, scr);
        if (two) p0_item_finish(db, F.lane, vb, scr);
    }
    __syncthreads();
}
#undef P0_DESC
__device__ __forceinline__ void p0_wait_mod(Frame& F) {
    unsigned spins = 0;
    while (__hip_atomic_load(F.ctl + CW_MODCNT, __ATOMIC_RELAXED, __HIP_MEMORY_SCOPE_AGENT) < 96u) { __builtin_amdgcn_s_sleep(8); if (++spins > (1u << 22)) break; }
}

__device__ __forceinline__ void p1_norm(Frame& F) {
    const int gw = F.vcu * NWAVES + F.wave, NGW = F.G * NWAVES;
    int bcur = -1; f32x4 shv[4], scv[4], nwv[4];
    for (int m = 4 * gw; m < M; m += 4 * NGW) {
        const int b = m >> 13;
        if (b != bcur) { bcur = b;
#pragma unroll
            for (int j = 0; j < 4; ++j) { const int c0 = 8 * F.lane + 512 * (j >> 1) + 4 * (j & 1); nwv[j] = *(const f32x4*)(F.norm_w + c0);
#pragma unroll
                for (int k = 0; k < 4; ++k) { const int cidx = c0 + k;
                    shv[j][k] = __hip_atomic_load(F.MOD + b * 3072 + cidx, __ATOMIC_RELAXED, __HIP_MEMORY_SCOPE_AGENT) + F.b_ada[cidx];
                    scv[j][k] = __hip_atomic_load(F.MOD + b * 3072 + 1024 + cidx, __ATOMIC_RELAXED, __HIP_MEMORY_SCOPE_AGENT) + F.b_ada[1024 + cidx] + 1.0f; } } }
        const GAS f32x4* xr = (const GAS f32x4*)(F.x + (size_t)m * D) + 2 * F.lane;
        f32x4 v[4][4]; float sq[4];
#pragma unroll
        for (int r = 0; r < 4; ++r)
#pragma unroll
            for (int j = 0; j < 4; ++j) v[r][j] = __builtin_nontemporal_load(xr + 256 * r + 128 * (j >> 1) + (j & 1));
#pragma unroll
        for (int r = 0; r < 4; ++r) { sq[r] = 0.f;
#pragma unroll
            for (int j = 0; j < 4; ++j) sq[r] += (v[r][j].x * v[r][j].x + v[r][j].y * v[r][j].y) + (v[r][j].z * v[r][j].z + v[r][j].w * v[r][j].w); }
#pragma unroll
        for (int o = 1; o < 64; o <<= 1) {
#pragma unroll
            for (int r = 0; r < 4; ++r) sq[r] += __shfl_xor(sq[r], o); }
        GAS v4u* o16 = (GAS v4u*)(F.XN + (size_t)m * D) + F.lane;
#pragma unroll
        for (int r = 0; r < 4; ++r) { const float rs = 1.f / sqrtf(sq[r] * (1.f / D) + EPS);
#pragma unroll
            for (int jj = 0; jj < 2; ++jj) { const f32x4 h0 = v[r][2 * jj] * rs * nwv[2 * jj] * scv[2 * jj] + shv[2 * jj], h1 = v[r][2 * jj + 1] * rs * nwv[2 * jj + 1] * scv[2 * jj + 1] + shv[2 * jj + 1];
                v4u w; w.x = pk2(h0.x, h0.y); w.y = pk2(h0.z, h0.w); w.z = pk2(h1.x, h1.y); w.w = pk2(h1.z, h1.w);
                o16[128 * r + 64 * jj] = w; } }
    }
}

__device__ __forceinline__ void p5_scan(Frame& F) {
    const int gtid = F.vcu * 512 + F.tid, NT = F.G * 512;
    for (int e = gtid; e < BATCH * SH * 8192 / 2; e += NT) {
        const int bh = e >> 12, pn = (e & 4095) * 2, b = bh >> 5, h = bh & 31;
        float r0 = 0.f, r1 = 0.f;
        for (int c = 0; c < NCH; ++c) {
            const int u = (b * NCH + c) * SH + h;
            GAS unsigned* sp = (GAS unsigned*)(F.ST + (size_t)u * 8192 + pn);
            const unsigned w = *sp; const float dec = F.CDEC[u];
            *sp = pk2(r0, r1);
            r0 = r0 * dec + blo(w); r1 = r1 * dec + bhi(w);
        }
    }
}


typedef float f32x16 __attribute__((ext_vector_type(16)));
typedef short s16x4 __attribute__((ext_vector_type(4)));
typedef short v4i16_t __attribute__((ext_vector_type(4)));
typedef unsigned v2u __attribute__((ext_vector_type(2)));
typedef float f32x2_t __attribute__((ext_vector_type(2))); typedef __bf16 bf16x2_t __attribute__((ext_vector_type(2)));
#define MFMA32(a, b, c) __builtin_amdgcn_mfma_f32_32x32x16_bf16((a), (b), (c), 0, 0, 0)
__device__ __forceinline__ unsigned cvtpk(float lo, float hi) { f32x2_t v = {lo, hi}; bf16x2_t b = __builtin_convertvector(v, bf16x2_t); return __builtin_bit_cast(unsigned, b); }
__device__ __forceinline__ s16x4 trr(LAS const unsigned char* p) { return __builtin_bit_cast(s16x4, __builtin_amdgcn_ds_read_tr16_b64_v4i16((LAS v4i16_t*)p)); }
__device__ __forceinline__ bf16x8 cat4(s16x4 lo, s16x4 hi) { return __builtin_shufflevector(lo, hi, 0, 1, 2, 3, 4, 5, 6, 7); }
__device__ __forceinline__ int crow(int reg, int h) { return (reg & 3) + 8 * (reg >> 2) + 4 * h; }
__device__ __forceinline__ bf16x8 pack_step(const f32x16& x, int s) {
    v4u p; p.x = cvtpk(x[8 * s], x[8 * s + 1]); p.y = cvtpk(x[8 * s + 2], x[8 * s + 3]); p.z = cvtpk(x[8 * s + 4], x[8 * s + 5]); p.w = cvtpk(x[8 * s + 6], x[8 * s + 7]);
    return __builtin_bit_cast(bf16x8, p);
}
__device__ __forceinline__ void unpack8(const v4u w, float* f) { f[0] = blo(w.x); f[1] = bhi(w.x); f[2] = blo(w.y); f[3] = bhi(w.y); f[4] = blo(w.z); f[5] = bhi(w.z); f[6] = blo(w.w); f[7] = bhi(w.w); }

__device__ __forceinline__ void p3_attn(Frame& F) {
    constexpr int KP = 144, VP = 192;
    constexpr float L2E = 1.4426950408889634f;
    LAS unsigned char* Kn = F.lds + RING_OFF;
    LAS unsigned char* Vs = F.lds + RING_OFF + 256 * KP;
    LAS float* tab = (LAS float*)(F.lds + SMALL_OFF);
    LAS unsigned char* Tw = F.lds + RING_OFF + 256 * KP + 256 * VP + F.wave * 4096;
    const int lane = F.lane, r32 = lane & 31, hh = lane >> 5, w = F.wave, g = w >> 1, qh = w & 1;
    const int blk = (lane >> 4) & 1, q4 = (lane & 15) >> 2, p4 = lane & 3;
    if ((F.G & 3) == 0) {
        const int hk0 = F.vcu & 3;
        for (int i = F.tid; i < 4 * 192; i += 512) { const int gg = i / 192, dist = i % 192 - 32;
            tab[i] = (dist >= 0 && dist < 128) ? F.rel_bias[t5_bucket(dist) * NHEAD + hk0 * 4 + gg] * L2E : -INFINITY; }
    }
    v4u qnext[4];
    if (F.vcu < BATCH * (SEQ / 128) * NKV) { const int u0 = F.vcu; const bf16* qg = F.Q + ((size_t)(u0 >> 8) * SEQ + (size_t)((u0 >> 2) & 63) * 128 + 64 * qh + (lane >> 3)) * D + ((u0 & 3) * 4 + g) * HD + (lane & 7) * 8;
#pragma unroll
        for (int i = 0; i < 4; ++i) qnext[i] = *(const GAS v4u*)(qg + (size_t)(8 * i) * D); }
    for (int u = F.vcu; u < BATCH * (SEQ / 128) * NKV; u += F.G) {
        const int hk = u & 3, nb = (u >> 2) & 63, b = u >> 8;
        const size_t tok0 = (size_t)b * SEQ + (size_t)nb * 128;
        if ((F.G & 3) != 0) { for (int i = F.tid; i < 4 * 192; i += 512) { const int gg = i / 192, dist = i % 192 - 32;
            tab[i] = (dist >= 0 && dist < 128) ? F.rel_bias[t5_bucket(dist) * NHEAD + hk * 4 + gg] * L2E : -INFINITY; } }
        const int head = hk * 4 + g;
        {
            const int key = F.tid >> 1, half = F.tid & 1;
            const bool valid = (nb > 0) || (key >= 128);
            const size_t krow = valid ? (tok0 + key - 128) : tok0;
            const bf16* kp = F.KB + krow * 256 + hk * HD + half * 32;
            const bf16* vp = F.VB + krow * 256 + hk * HD + half * 32;
            v4u kw[4], vw[4];
#pragma unroll
            for (int i = 0; i < 4; ++i) { kw[i] = *(const GAS v4u*)(kp + 8 * i); vw[i] = *(const GAS v4u*)(vp + 8 * i); }
            if (!valid) {
#pragma unroll
                for (int i = 0; i < 4; ++i) { kw[i] = (v4u){0u, 0u, 0u, 0u}; vw[i] = (v4u){0u, 0u, 0u, 0u}; } }
            float kf[32]; float ss = 0.f;
#pragma unroll
            for (int i = 0; i < 4; ++i) unpack8(kw[i], kf + 8 * i);
#pragma unroll
            for (int i = 0; i < 32; ++i) ss += kf[i] * kf[i];
            ss += __shfl_xor(ss, 1);
            const float rs = 1.f / sqrtf(ss * (1.f / 64.f) + EPS);
#pragma unroll
            for (int i = 0; i < 4; ++i) { const f32x4 w0 = *(const f32x4*)(F.k_norm_w + half * 32 + 8 * i), w1 = *(const f32x4*)(F.k_norm_w + half * 32 + 8 * i + 4);
                v4u o; o.x = cvtpk(kf[8 * i] * rs * w0[0], kf[8 * i + 1] * rs * w0[1]); o.y = cvtpk(kf[8 * i + 2] * rs * w0[2], kf[8 * i + 3] * rs * w0[3]);
                o.z = cvtpk(kf[8 * i + 4] * rs * w1[0], kf[8 * i + 5] * rs * w1[1]); o.w = cvtpk(kf[8 * i + 6] * rs * w1[2], kf[8 * i + 7] * rs * w1[3]);
                *(LAS v4u*)(Kn + key * KP + half * 64 + 16 * i) = o;
                *(LAS v4u*)(Vs + key * VP + half * 64 + 16 * i) = vw[i]; }
        }
        __syncthreads();
        const float sinkl = F.sinks[head] * L2E;
        const bool first = (nb == 0);
#pragma unroll 1
        for (int sb = 0; sb < 2; ++sb) {
            const int qi0 = 64 * qh + 32 * sb, kt0 = qi0 >> 5;
            bf16x8 qf[4];
            {
#pragma unroll
                for (int i = 0; i < 4; ++i) { const int r = 8 * i + (lane >> 3); *(LAS v4u*)(Tw + r * 128 + (((lane & 7) ^ ((r >> 1) & 7)) << 4)) = qnext[i]; }
                {
                    const int un = sb == 0 ? u : u + F.G;
                    if (un < BATCH * (SEQ / 128) * NKV) { const bf16* qg = F.Q + ((size_t)(un >> 8) * SEQ + (size_t)((un >> 2) & 63) * 128 + 64 * qh + (sb == 0 ? 32 : 0) + (lane >> 3)) * D + ((un & 3) * 4 + g) * HD + (lane & 7) * 8;
#pragma unroll
                        for (int i = 0; i < 4; ++i) qnext[i] = *(const GAS v4u*)(qg + (size_t)(8 * i) * D); }
                }
                v4u qr[4]; float qv[32]; float ss = 0.f;
#pragma unroll
                for (int ks = 0; ks < 4; ++ks) { qr[ks] = *(const LAS v4u*)(Tw + r32 * 128 + (((2 * ks + hh) ^ ((r32 >> 1) & 7)) << 4)); unpack8(qr[ks], qv + 8 * ks); }
#pragma unroll
                for (int i = 0; i < 32; ++i) ss += qv[i] * qv[i];
                ss += __shfl_xor(ss, 32);
                const float qs = 0.125f * L2E / sqrtf(ss * (1.f / 64.f) + EPS);
#pragma unroll
                for (int ks = 0; ks < 4; ++ks) { const f32x4 w0 = *(const f32x4*)(F.q_norm_w + 16 * ks + 8 * hh), w1 = *(const f32x4*)(F.q_norm_w + 16 * ks + 8 * hh + 4);
                    v4u o; o.x = cvtpk(qv[8 * ks] * qs * w0[0], qv[8 * ks + 1] * qs * w0[1]); o.y = cvtpk(qv[8 * ks + 2] * qs * w0[2], qv[8 * ks + 3] * qs * w0[3]);
                    o.z = cvtpk(qv[8 * ks + 4] * qs * w1[0], qv[8 * ks + 5] * qs * w1[1]); o.w = cvtpk(qv[8 * ks + 6] * qs * w1[2], qv[8 * ks + 7] * qs * w1[3]);
                    qf[ks] = __builtin_bit_cast(bf16x8, o); }
            }
            v4u zr4[4];
#pragma unroll
            for (int i = 0; i < 4; ++i) zr4[i] = *(const GAS v4u*)(F.ZA + (tok0 + qi0 + (lane >> 3) + 8 * i) * D + head * HD + (lane & 7) * 8);
            f32x16 X[5];
#pragma unroll
            for (int t = 0; t < 5; ++t) {
#pragma unroll
                for (int i = 0; i < 16; ++i) X[t][i] = tab[g * 192 + r32 + 160 - 32 * t - crow(i, hh)];
                const LAS unsigned char* kb = Kn + (32 * (kt0 + t) + r32) * KP + 16 * hh;
#pragma unroll
                for (int ks = 0; ks < 4; ++ks) { const bf16x8 a = *(const LAS bf16x8*)(kb + 32 * ks); X[t] = MFMA32(a, qf[ks], X[t]); }
            }
            if (first) {
#pragma unroll
                for (int t = 0; t < 5; ++t) if (kt0 + t < 4) {
#pragma unroll
                    for (int i = 0; i < 16; ++i) X[t][i] = -INFINITY; }
            }
            float mx = sinkl;
#pragma unroll
            for (int t = 0; t < 5; ++t)
#pragma unroll
                for (int i = 0; i < 16; ++i) mx = fmaxf(mx, X[t][i]);
            mx = fmaxf(mx, __shfl_xor(mx, 32));
            float sum = 0.f;
#pragma unroll
            for (int t = 0; t < 5; ++t)
#pragma unroll
                for (int i = 0; i < 16; ++i) { const float p = __builtin_amdgcn_exp2f(X[t][i] - mx); X[t][i] = p; sum += p; }
            sum += __shfl_xor(sum, 32);
            sum += __builtin_amdgcn_exp2f(sinkl - mx);
            f32x16 O[2];
#pragma unroll
            for (int i = 0; i < 16; ++i) { O[0][i] = 0.f; O[1][i] = 0.f; }
#pragma unroll
            for (int t = 0; t < 5; ++t)
#pragma unroll
                for (int s = 0; s < 2; ++s) { const bf16x8 pk = pack_step(X[t], s);
                    const LAS unsigned char* vb = Vs + (32 * (kt0 + t) + 16 * s + 4 * hh + q4) * VP + 32 * blk + 8 * p4;
#pragma unroll
                    for (int dt = 0; dt < 2; ++dt) { const bf16x8 a = cat4(trr(vb + 64 * dt), trr(vb + 8 * VP + 64 * dt)); O[dt] = MFMA32(a, pk, O[dt]); } }
            const float inv = 1.f / sum;
            {
#pragma unroll
                for (int i = 0; i < 4; ++i) { const int r = 8 * i + (lane >> 3); *(LAS v4u*)(Tw + r * 128 + (((lane & 7) ^ ((r >> 1) & 7)) << 4)) = zr4[i]; }
                LAS unsigned char* tr = Tw + r32 * 128 + 8 * hh; const int sw = (r32 >> 1) & 7;
#pragma unroll
                for (int dt = 0; dt < 2; ++dt)
#pragma unroll
                    for (int qd = 0; qd < 4; ++qd) { LAS v2u* pz = (LAS v2u*)(tr + (((4 * dt + qd) ^ sw) << 4)); const v2u z = *pz; v2u o;
                        o.x = cvtpk(O[dt][4 * qd] * inv * blo(z.x), O[dt][4 * qd + 1] * inv * bhi(z.x)); o.y = cvtpk(O[dt][4 * qd + 2] * inv * blo(z.y), O[dt][4 * qd + 3] * inv * bhi(z.y));
                        *pz = o; }
                bf16* og = F.Q + (tok0 + qi0 + (lane >> 3)) * D + head * HD + (lane & 7) * 8;
#pragma unroll
                for (int i = 0; i < 4; ++i) { const int r = 8 * i + (lane >> 3); const v4u v = *(const LAS v4u*)(Tw + r * 128 + (((lane & 7) ^ ((r >> 1) & 7)) << 4)); *(GAS v4u*)(og + (size_t)(8 * i) * D) = v; }
            }
        }
        __syncthreads();
    }
}

__device__ __forceinline__ void conv8_load(const bf16* XBC, size_t rowb, int t, int gc, v4u (&raw)[7], const bf16* pre, bool prev_ok) {
#pragma unroll
    for (int i = 0; i < 7; ++i) { const int tt = t - 3 + i;
        raw[i] = (v4u){0u, 0u, 0u, 0u};
        if (i < 3) { if (prev_ok) raw[i] = *(const GAS v4u*)(pre ? pre + i * 2048 : XBC + (rowb + tt) * XBCW + gc); }
        else raw[i] = *(const GAS v4u*)(XBC + (rowb + tt) * XBCW + gc); }
}
__device__ __forceinline__ void conv8_apply(const float* cw, const float* cb, int gc, const v4u (&raw)[7], float (&o)[4][8]) {
    float w[4][8];
#pragma unroll
    for (int j = 0; j < 4; ++j) { const f32x4 a = *(const f32x4*)(cw + j * XBCW + gc), c = *(const f32x4*)(cw + j * XBCW + gc + 4);
        w[j][0] = a[0]; w[j][1] = a[1]; w[j][2] = a[2]; w[j][3] = a[3]; w[j][4] = c[0]; w[j][5] = c[1]; w[j][6] = c[2]; w[j][7] = c[3]; }
    { const f32x4 a = *(const f32x4*)(cb + gc), c = *(const f32x4*)(cb + gc + 4);
#pragma unroll
      for (int r = 0; r < 4; ++r) { o[r][0] = a[0]; o[r][1] = a[1]; o[r][2] = a[2]; o[r][3] = a[3]; o[r][4] = c[0]; o[r][5] = c[1]; o[r][6] = c[2]; o[r][7] = c[3]; } }
#pragma unroll
    for (int i = 0; i < 7; ++i) { float x[8]; unpack8(raw[i], x);
#pragma unroll
        for (int r = 0; r < 4; ++r) { const int j = i - r;
            if (j >= 0 && j < 4) {
#pragma unroll
                for (int k = 0; k < 8; ++k) o[r][k] += w[j][k] * x[k]; } } }
#pragma unroll
    for (int r = 0; r < 4; ++r)
#pragma unroll
        for (int k = 0; k < 8; ++k) o[r][k] = o[r][k] * __builtin_amdgcn_rcpf(1.f + __builtin_amdgcn_exp2f(-1.4426950408889634f * o[r][k]));
}
__device__ __forceinline__ v4u pack8(const float* f, float s) { v4u o; o.x = cvtpk(f[0] * s, f[1] * s); o.y = cvtpk(f[2] * s, f[3] * s); o.z = cvtpk(f[4] * s, f[5] * s); o.w = cvtpk(f[6] * s, f[7] * s); return o; }

__device__ __forceinline__ void chunk_cumsum(const float* DT, size_t row0, int hd, float a, int lane, float& d0, float& d1, float& ac0, float& ac1, float& aend) {
    { const f32x2_t dd = *(const GAS f32x2_t*)(DT + ((row0 >> 7) * 32 + hd) * 128 + 2 * lane); d0 = dd[0]; d1 = dd[1]; }
    const float v1 = d1 * a; float s = d0 * a + v1;
#pragma unroll
    for (int o = 1; o < 64; o <<= 1) { const float t = __shfl_up(s, o); if (lane >= o) s += t; }
    aend = __shfl(s, 63); ac1 = s; ac0 = s - v1;
}

__device__ __forceinline__ void p4_states(Frame& F) {
    constexpr int XP = 576, BP = 320;
    LAS unsigned char* Xw = F.lds + RING_OFF;
    LAS unsigned char* Bs = F.lds + RING_OFF + 128 * XP;
    LAS float* sW = (LAS float*)(F.lds + SMALL_OFF);
    const int lane = F.lane, r32 = lane & 31, hh = lane >> 5, w = F.wave, hl = w >> 1, nh = w & 1;
    const int blk = (lane >> 4) & 1, q4 = (lane & 15) >> 2, p4 = lane & 3;
    v4u raw[3][7];
#define P4_ISSUE(un) do { const int hq_ = (un) & 1, g_ = ((un) >> 1) & 3, c_ = ((un) >> 3) & 63, b_ = (un) >> 9; const size_t rowb_ = (size_t)b_ * SEQ; \
        _Pragma("unroll") for (int k_ = 0; k_ < 3; ++k_) { const int it_ = F.tid + 512 * k_, ch_ = it_ % 48, rg_ = it_ / 48, l0_ = rg_ * 4; \
            if (ch_ < 32) { const int gc_ = (g_ * 8 + hq_ * 4) * 64 + ch_ * 8; const bool first_ = (rg_ == 0); \
                conv8_load(F.XBC, rowb_, c_ * CH + l0_, gc_, raw[k_], first_ ? F.HALO + ((size_t)(b_ * NCH + c_ - 1) * 3) * 2048 + gc_ : nullptr, !first_ || c_ > 0); } \
            else { const int gc_ = SSMW + g_ * SN + (ch_ - 32) * 8; conv8_load(F.XBC, rowb_, c_ * CH + l0_, gc_, raw[k_], nullptr, c_ * CH + l0_ > 0); } } } while (0)
    if (F.vcu < BATCH * NCH * SG * 2) P4_ISSUE(F.vcu);
    for (int u = F.vcu; u < BATCH * NCH * SG * 2; u += F.G) {
        const int hq = u & 1, g = (u >> 1) & 3, c = (u >> 3) & 63, b = u >> 9;
        const int t0 = c * CH; const size_t rowb = (size_t)b * SEQ, row0 = rowb + t0;
        if (w < 4) { const int hd = g * 8 + hq * 4 + w; float d0, d1, ac0, ac1, aend; int ln = lane; asm volatile("" : "+v"(ln));
            chunk_cumsum(F.DT, row0, hd, -__expf(F.a_log[hd]), ln, d0, d1, ac0, ac1, aend);
            sW[w * 128 + 2 * ln] = d0 * __expf(aend - ac0); sW[w * 128 + 2 * ln + 1] = d1 * __expf(aend - ac1);
            if (ln == 63) F.CDEC[(b * NCH + c) * SH + hd] = __expf(aend); }
#pragma unroll
        for (int itk = 0; itk < 3; ++itk) { const int it = F.tid + 512 * itk;
            const int ch = it % 48, rg = it / 48, l0 = rg * 4;
            float o[4][8];
            if (ch < 32) {
                conv8_apply(F.conv_w, F.conv_b, (g * 8 + hq * 4) * 64 + ch * 8, raw[itk], o);
#pragma unroll
                for (int r = 0; r < 4; ++r) *(LAS v4u*)(Xw + (l0 + r) * XP + ch * 16) = pack8(o[r], 1.f);
            } else {
                conv8_apply(F.conv_w, F.conv_b, SSMW + g * SN + (ch - 32) * 8, raw[itk], o);
#pragma unroll
                for (int r = 0; r < 4; ++r) *(LAS v4u*)(Bs + (l0 + r) * BP + (ch - 32) * 16) = pack8(o[r], 1.f);
            }
        }
        __syncthreads();
        if (u + F.G < BATCH * NCH * SG * 2) P4_ISSUE(u + F.G);
        f32x16 acc[2][2];
#pragma unroll
        for (int i = 0; i < 16; ++i) { acc[0][0][i] = 0.f; acc[0][1][i] = 0.f; acc[1][0][i] = 0.f; acc[1][1][i] = 0.f; }
        const LAS unsigned char* ab = Bs + (8 * hh + q4) * BP + 128 * nh + 32 * blk + 8 * p4;
        const LAS unsigned char* bb = Xw + (8 * hh + q4) * XP + 128 * hl + 32 * blk + 8 * p4;
        bf16* xt = F.XBC + (row0 + (size_t)(hl * 32 + hh)) * XBCW + g * 512 + hq * 256 + r32 * 8;
#pragma unroll 2
        for (int ks = 0; ks < 8; ++ks) {
            bf16x8 A[2], B[2];
#pragma unroll
            for (int nt = 0; nt < 2; ++nt) A[nt] = cat4(trr(ab + 16 * ks * BP + 64 * nt), trr(ab + (16 * ks + 4) * BP + 64 * nt));
#pragma unroll
            for (int pt = 0; pt < 2; ++pt) B[pt] = cat4(trr(bb + 16 * ks * XP + 64 * pt), trr(bb + (16 * ks + 4) * XP + 64 * pt));
            {
                const f32x4 w0 = *(const LAS f32x4*)(sW + hl * 128 + 16 * ks + 8 * hh), w1 = *(const LAS f32x4*)(sW + hl * 128 + 16 * ks + 8 * hh + 4);
#pragma unroll
                for (int nt = 0; nt < 2; ++nt) { const v4u a = __builtin_bit_cast(v4u, A[nt]); v4u o;
                    o.x = cvtpk(blo(a.x) * w0[0], bhi(a.x) * w0[1]); o.y = cvtpk(blo(a.y) * w0[2], bhi(a.y) * w0[3]); o.z = cvtpk(blo(a.z) * w1[0], bhi(a.z) * w1[1]); o.w = cvtpk(blo(a.w) * w1[2], bhi(a.w) * w1[3]);
                    A[nt] = __builtin_bit_cast(bf16x8, o); }
            }
            if (nh == 0) {
#pragma unroll
                for (int pt = 0; pt < 2; ++pt) *(GAS v4u*)(xt + (size_t)((ks * 2 + pt) * 2) * XBCW) = __builtin_bit_cast(v4u, B[pt]);
            }
#pragma unroll
            for (int nt = 0; nt < 2; ++nt)
#pragma unroll
                for (int pt = 0; pt < 2; ++pt) acc[nt][pt] = MFMA32(A[nt], B[pt], acc[nt][pt]);
        }
        {
            const int hd = g * 8 + hq * 4 + hl;
            bf16* sp = F.ST + (size_t)((b * NCH + c) * SH + hd) * 8192;
#pragma unroll
            for (int nt = 0; nt < 2; ++nt)
#pragma unroll
                for (int pt = 0; pt < 2; ++pt)
#pragma unroll
                    for (int qd = 0; qd < 4; ++qd) { v2u o; o.x = cvtpk(acc[nt][pt][4 * qd], acc[nt][pt][4 * qd + 1]); o.y = cvtpk(acc[nt][pt][4 * qd + 2], acc[nt][pt][4 * qd + 3]);
                        *(GAS v2u*)(sp + (((2 * (2 * nh + nt) + (qd >> 1)) * 2 + pt) * 64 + (qd & 1) * 32 + r32) * 8 + 4 * hh) = o; }
        }
        __syncthreads();
    }
#undef P4_ISSUE
}

__device__ __forceinline__ void p6_scan(Frame& F) {
    constexpr int CP = 272;
    LAS unsigned char* Cs = F.lds + RING_OFF;
    LAS unsigned char* Bs = F.lds + RING_OFF + 128 * CP;
    LAS float* sDT = (LAS float*)(F.lds + SMALL_OFF);
    LAS float* sAC = sDT + 1024;
    LAS float* ssq = sDT + 2048;
    LAS float* sES = ssq;
    const int lane = F.lane, r32 = lane & 31, hh = lane >> 5, w = F.wave;
    for (int u = F.vcu; u < BATCH * NCH * SG; u += F.G) {
        const int g = u & 3, c = (u >> 2) & 63, b = u >> 8;
        const int t0 = c * CH; const size_t rowb = (size_t)b * SEQ, row0 = rowb + t0;
        const int hd = g * 8 + w;
        { float d0, d1, ac0, ac1, aend; int ln = lane; asm volatile("" : "+v"(ln));
          chunk_cumsum(F.DT, row0, hd, -__expf(F.a_log[hd]), ln, d0, d1, ac0, ac1, aend);
          sDT[w * 128 + 2 * ln] = d0; sDT[w * 128 + 2 * ln + 1] = d1; sAC[w * 128 + 2 * ln] = ac0; sAC[w * 128 + 2 * ln + 1] = ac1;
          const float et = __shfl(ac1, 16 * (ln >> 4) + 15);
          sES[w * 128 + 2 * ln] = d0 * __expf(et - ac0); sES[w * 128 + 2 * ln + 1] = d1 * __expf(et - ac1); }
        {
            v4u raw[2][7];
#pragma unroll
            for (int it2 = 0; it2 < 2; ++it2) { const int it = F.tid + 512 * it2, ch = it & 31, l0 = (it >> 5) * 4;
                conv8_load(F.XBC, rowb, t0 + l0, SSMW + (ch < 16 ? 0 : SG * SN) + g * SN + (ch & 15) * 8, raw[it2], nullptr, t0 + l0 > 0); }
#pragma unroll
            for (int it2 = 0; it2 < 2; ++it2) { const int it = F.tid + 512 * it2, ch = it & 31, l0 = (it >> 5) * 4;
                float o[4][8];
                conv8_apply(F.conv_w, F.conv_b, SSMW + (ch < 16 ? 0 : SG * SN) + g * SN + (ch & 15) * 8, raw[it2], o);
                LAS unsigned char* dst = (ch < 16 ? Bs : Cs) + l0 * CP + (ch & 15) * 16;
#pragma unroll
                for (int r = 0; r < 4; ++r) *(LAS v4u*)(dst + r * CP) = pack8(o[r], 1.f);
                asm volatile("" ::: "memory"); }
        }
        bf16x8 HA[8][2];
        { int ln2 = lane; asm volatile("" : "+v"(ln2));
          const bf16* hp = F.ST + (size_t)((b * NCH + c) * SH + hd) * 8192 + ln2 * 8;
#pragma unroll
          for (int ks = 0; ks < 8; ++ks)
#pragma unroll
              for (int pt = 0; pt < 2; ++pt) HA[ks][pt] = __builtin_bit_cast(bf16x8, *(const GAS v4u*)(hp + (ks * 2 + pt) * 512)); }
        __syncthreads();
        f32x16 yacc[4][2];
#pragma unroll
        for (int lt = 0; lt < 4; ++lt)
#pragma unroll
            for (int i = 0; i < 16; ++i) { yacc[lt][0][i] = 0.f; yacc[lt][1][i] = 0.f; }
        {
            const LAS unsigned char* cb = Cs + r32 * CP + 16 * hh;
#pragma unroll
            for (int ks = 0; ks < 8; ++ks) {
                bf16x8 Bf[4];
#pragma unroll
                for (int lt = 0; lt < 4; ++lt) Bf[lt] = *(const LAS bf16x8*)(cb + 32 * lt * CP + 32 * ks);
#pragma unroll
                for (int lt = 0; lt < 4; ++lt)
#pragma unroll
                    for (int pt = 0; pt < 2; ++pt) yacc[lt][pt] = MFMA32(HA[ks][pt], Bf[lt], yacc[lt][pt]);
                if (ks & 1) asm volatile("" ::: "memory");
            }
#pragma unroll
            for (int lt = 0; lt < 4; ++lt) { const float e = __expf(sAC[w * 128 + 32 * lt + r32]);
#pragma unroll
                for (int i = 0; i < 16; ++i) { yacc[lt][0][i] *= e; yacc[lt][1][i] *= e; } }
        }
        const float dsk = F.d_skip[hd];
        const bf16* xt = F.XBC + (row0 + (size_t)((w & 3) * 32)) * XBCW + g * 512 + (w >> 2) * 256 + r32 * 8 + 4 * hh;
#pragma unroll 1
        for (int st = 0; st < 4; ++st) {
            v2u xr[2][2][2];
#pragma unroll
            for (int s = 0; s < 2; ++s)
#pragma unroll
                for (int pt = 0; pt < 2; ++pt)
#pragma unroll
                    for (int hf = 0; hf < 2; ++hf) xr[s][pt][hf] = *(const GAS v2u*)(xt + (size_t)(((2 * st + s) * 2 + pt) * 2 + hf) * XBCW);
            const LAS unsigned char* ab = Bs + (32 * st + r32) * CP + 16 * hh;
#pragma unroll
            for (int lt = 0; lt < 4; ++lt) {
                if (lt >= st) {
                    f32x16 X;
#pragma unroll
                    for (int i = 0; i < 16; ++i) X[i] = 0.f;
                    const LAS unsigned char* cb = Cs + (32 * lt + r32) * CP + 16 * hh; const float acl_lt = sAC[w * 128 + 32 * lt + r32];
#pragma unroll 2
                    for (int ks = 0; ks < 8; ++ks) X = MFMA32(*(const LAS bf16x8*)(ab + 32 * ks), *(const LAS bf16x8*)(cb + 32 * ks), X);
                    if (lt == st) {
#pragma unroll
                        for (int qd = 0; qd < 4; ++qd) { const int sl0 = 8 * qd + 4 * hh;
                            const f32x4 av = *(const LAS f32x4*)(sAC + w * 128 + 32 * st + sl0), dv = *(const LAS f32x4*)(sDT + w * 128 + 32 * st + sl0);
#pragma unroll
                            for (int k = 0; k < 4; ++k) { float f = __expf(acl_lt - av[k]) * dv[k];
                                if (sl0 + k > r32) f = 0.f;
                                float v = X[4 * qd + k] * f;
                                if (sl0 + k == r32) v += dsk;
                                X[4 * qd + k] = v; }
                            asm volatile("" ::: "memory"); }
                    } else {
                        const float cl = __expf(acl_lt - sAC[w * 128 + 32 * st + 31]);
#pragma unroll
                        for (int qd = 0; qd < 4; ++qd) { const f32x4 ev = *(const LAS f32x4*)(sES + w * 128 + 32 * st + 8 * qd + 4 * hh);
#pragma unroll
                            for (int k = 0; k < 4; ++k) X[4 * qd + k] *= cl * ev[k]; }
                    }
#pragma unroll
                    for (int s = 0; s < 2; ++s) { const bf16x8 xp = pack_step(X, s);
#pragma unroll
                        for (int pt = 0; pt < 2; ++pt) { const v4u xa = (v4u){xr[s][pt][0].x, xr[s][pt][0].y, xr[s][pt][1].x, xr[s][pt][1].y};
                            yacc[lt][pt] = MFMA32(__builtin_bit_cast(bf16x8, xa), xp, yacc[lt][pt]); } }
                }
            }
        }
        LAS unsigned char* Yw = F.lds + RING_OFF + w * 16384;
        {
            int ln4 = lane; asm volatile("" : "+v"(ln4));
            const bf16* zg = F.ZM + (size_t)(hd >> 4) * M * 1024 + (row0 + (ln4 >> 3)) * 1024 + (hd & 15) * 64 + (ln4 & 7) * 8;
            v4u zr[8];
#pragma unroll
            for (int i = 0; i < 8; ++i) zr[i] = *(const GAS v4u*)(zg + (size_t)(8 * i) * 1024);
            __syncthreads();
#pragma unroll 1
            for (int hb = 0; hb < 2; ++hb) {
#pragma unroll
                for (int i = 0; i < 8; ++i) { const int t = 8 * (8 * hb + i) + (lane >> 3); *(LAS v4u*)(Yw + t * 128 + (((lane & 7) ^ ((t >> 1) & 7)) << 4)) = zr[i]; }
                if (hb == 0) {
#pragma unroll
                    for (int i = 0; i < 8; ++i) zr[i] = *(const GAS v4u*)(zg + (size_t)(8 * (8 + i)) * 1024); }
                asm volatile("" ::: "memory"); }
        }
        float ss[4];
#pragma unroll
        for (int lt = 0; lt < 4; ++lt) { ss[lt] = 0.f; const int t = 32 * lt + r32; const LAS unsigned char* yr = Yw + t * 128 + 8 * hh; const int sw = (t >> 1) & 7;
#pragma unroll
            for (int pt = 0; pt < 2; ++pt)
#pragma unroll
                for (int qd = 0; qd < 4; ++qd) { const v2u z = *(const LAS v2u*)(yr + (((4 * pt + qd) ^ sw) << 4));
                    const float y0 = yacc[lt][pt][4 * qd] * blo(z.x), y1 = yacc[lt][pt][4 * qd + 1] * bhi(z.x), y2 = yacc[lt][pt][4 * qd + 2] * blo(z.y), y3 = yacc[lt][pt][4 * qd + 3] * bhi(z.y);
                    yacc[lt][pt][4 * qd] = y0; yacc[lt][pt][4 * qd + 1] = y1; yacc[lt][pt][4 * qd + 2] = y2; yacc[lt][pt][4 * qd + 3] = y3;
                    ss[lt] += (y0 * y0 + y1 * y1) + (y2 * y2 + y3 * y3); }
            ss[lt] += __shfl_xor(ss[lt], 32);
            if (hh == 0) ssq[w * 128 + t] = ss[lt];
            asm volatile("" ::: "memory"); }
        __syncthreads();
#pragma unroll
        for (int lt = 0; lt < 4; ++lt) { float tot = 0.f; const int t = 32 * lt + r32;
#pragma unroll
            for (int k = 0; k < 8; ++k) tot += ssq[k * 128 + t];
            const float rs = 1.f / sqrtf(tot * (1.f / 512.f) + EPS);
            LAS unsigned char* yr = Yw + t * 128 + 8 * hh; const int sw = (t >> 1) & 7; const float* nw = F.ssm_norm_w + hd * 64 + 4 * hh;
#pragma unroll
            for (int pt = 0; pt < 2; ++pt)
#pragma unroll
                for (int qd = 0; qd < 4; ++qd) { const f32x4 wv = *(const f32x4*)(nw + 32 * pt + 8 * qd); v2u o;
                    o.x = cvtpk(yacc[lt][pt][4 * qd] * rs * wv[0], yacc[lt][pt][4 * qd + 1] * rs * wv[1]); o.y = cvtpk(yacc[lt][pt][4 * qd + 2] * rs * wv[2], yacc[lt][pt][4 * qd + 3] * rs * wv[3]);
                    *(LAS v2u*)(yr + (((4 * pt + qd) ^ sw) << 4)) = o; }
            asm volatile("" ::: "memory"); }
        {
            int ln3 = lane; asm volatile("" : "+v"(ln3));
            bf16* zg = F.ZM + (size_t)(hd >> 4) * M * 1024 + (row0 + (ln3 >> 3)) * 1024 + (hd & 15) * 64 + (ln3 & 7) * 8;
#pragma unroll 4
            for (int i = 0; i < 16; ++i) { const int t = 8 * i + (lane >> 3); const v4u v = *(const LAS v4u*)(Yw + t * 128 + (((lane & 7) ^ ((t >> 1) & 7)) << 4)); *(GAS v4u*)(zg + (size_t)(8 * i) * 1024) = v; if ((i & 3) == 3) asm volatile("" ::: "memory"); }
        }
        __syncthreads();
    }
}

struct Args { const float* in[19]; float* out; unsigned char* ws; int ph_lo, ph_hi, li, pad; };
__global__ void __launch_bounds__(NWAVES * 64, 2) mk_fwd(Args args) {
    extern __shared__ __attribute__((aligned(16))) unsigned char lds[];
    Frame F;
    F.lds = (LAS unsigned char*)lds;
    F.MISC = (volatile LAS unsigned*)(F.lds + MISC_OFF);
    F.tid = threadIdx.x; F.lane = F.tid & 63; F.wave = __builtin_amdgcn_readfirstlane(F.tid >> 6);
    F.G = gridDim.x; { const int bx = blockIdx.x; F.vcu = (F.G % 8 == 0) ? (bx % 8) * (F.G / 8) + bx / 8 : bx; }
    unsigned char* ws = args.ws;
    F.ctl = (gu32*)(ws + WS_CTL);
    F.x = args.in[0]; F.c = args.in[1]; F.w_ada = args.in[2]; F.b_ada = args.in[3]; F.norm_w = args.in[4]; F.w_in = args.in[5]; F.q_norm_w = args.in[6]; F.k_norm_w = args.in[7];
    F.rel_bias = args.in[8]; F.sinks = args.in[9]; F.conv_w = args.in[10]; F.conv_b = args.in[11]; F.dt_bias = args.in[12]; F.a_log = args.in[13]; F.d_skip = args.in[14];
    F.ssm_norm_w = args.in[15]; F.w_attn = args.in[16]; F.w_ssm = args.in[17]; F.w_out = args.in[18]; F.out = args.out;
    F.WIN = (bf16*)(ws + WS_WIN); F.WA = (bf16*)(ws + WS_WA); F.WS = (bf16*)(ws + WS_WS); F.WO = (bf16*)(ws + WS_WO);
    F.XN = (bf16*)(ws + WS_XN); F.Q = (bf16*)(ws + WS_Q); F.ZM = (bf16*)(ws + WS_ZM); F.XBC = (bf16*)(ws + WS_XBC);
    F.HALO = (bf16*)(ws + WS_HALO); F.GA = (bf16*)(ws + WS_GA); F.GB = (bf16*)(ws + WS_GB); F.MG = (bf16*)(ws + WS_MG);
    F.KB = (bf16*)((unsigned char*)args.out + OUT_K); F.VB = (bf16*)((unsigned char*)args.out + OUT_V); F.ZA = (bf16*)((unsigned char*)args.out + OUT_ZA); F.ST = (bf16*)((unsigned char*)args.out + OUT_ST);
    F.MOD = (float*)(ws + WS_MISC); F.CDEC = (float*)(ws + WS_MISC + 32768); F.DT = (float*)(ws + WS_DT);
    for (int u = F.tid; u < (LDS_BYTES - LDSCTL_OFF) / 4; u += NWAVES * 64) ((LAS unsigned*)(F.lds + LDSCTL_OFF))[u] = 0u;
    __syncthreads();
    XcdBarrier bar; bar.bar = (unsigned*)(F.ctl + CW_BAR); bar.x = 0; bar.st = nullptr;
    if (N_LAUNCHES != PER_PHASE) bar = xcd_barrier_post((unsigned*)(F.ctl + CW_BAR), F.MISC + 8);
#define GRID_BAR() do { if (N_LAUNCHES != PER_PHASE) xcd_barrier(bar); } while (0)
    const int lo = args.ph_lo, hi = args.ph_hi;
#define IN(k) (lo <= (k) && (k) < hi)
#define BOTH(k) (IN(k) && IN((k) + 1))


#define PH0() do { if (IN(0)) { p0_prologue(F); } } while (0)
#define PH1() do { if (IN(1)) { p0_wait_mod(F); p1_norm(F); if (BOTH(1)) GRID_BAR(); } } while (0)
#define PH2() do { if (IN(2)) { \
        pg8::Gemm g{F.XN, F.WIN, M, N_MAIN, D}; pg8::StaticOrder S; S.init(M, N_MAIN, F.G, (int)blockIdx.x); \
        pg8::EpiInProj E{F.Q, F.KB, F.VB, F.ZA, F.ZM, F.XBC, F.GA, F.GB, F.DT, F.dt_bias, 0, F.HALO}; \
        pg8::gemm_phase<pg8::EpiInProj, pg8::StaticOrder, PG8_ALIGN, PG8_SP2>(F.lds + RING_OFF, g, S, E); \
        { const int nfull = (M / 256) * (N_MAIN / 256) % (int)F.G;     \
          if ((int)blockIdx.x >= nfull) p0_late(F, nfull); } \
        if (BOTH(2)) GRID_BAR(); } } while (0)
#define PH3() do { if (IN(3)) { p3_attn(F); if (BOTH(3)) GRID_BAR(); } } while (0)
#define PH4() do { if (IN(4)) { p4_states(F); if (BOTH(4)) GRID_BAR(); } } while (0)
#define PH5() do { if (IN(5)) { p5_scan(F); if (BOTH(5)) GRID_BAR(); } } while (0)
#define PH6() do { if (IN(6)) { p6_scan(F); if (BOTH(6)) GRID_BAR(); } } while (0)
#ifndef PAIR_BARRIER
#define PAIR_BARRIER 0
#endif
#define PH7() do { if (IN(7)) { \
        pg8::Gemm g{F.XN, F.WIN + (size_t)N_MAIN * D, M, N_GATE, D}; pg8::PairOrder S; S.base.init(M, D, F.G, (int)blockIdx.x); \
        pg8::EpiInProj E{F.Q, F.KB, F.VB, F.ZA, F.ZM, F.XBC, F.GA, F.GB, F.DT, F.dt_bias, 31, F.HALO}; \
        pg8::gemm_phase<pg8::EpiInProj, pg8::PairOrder, PG8_ALIGN, PG8_SP2>(F.lds + RING_OFF, g, S, E); \
        if (PAIR_BARRIER && BOTH(7)) GRID_BAR(); } } while (0)
#define PH8() do { if (IN(8)) { \
        { pg8::Gemm g{F.Q, F.WA, M, D, D}; pg8::StaticOrder S; S.init(M, D, F.G, (int)blockIdx.x); \
          pg8::EpiGate<0> E{F.GA, F.MG}; \
          pg8::gemm_phase<pg8::EpiGate<0>, pg8::StaticOrder, PG8_ALIGN, PG8_SP2>(F.lds + RING_OFF, g, S, E); } \
        { pg8::Gemm g{F.ZM, F.WS, M, D, D}; pg8::ChainOrder S; S.base.init(M, D, F.G, (int)blockIdx.x); S.ZM = F.ZM; S.WS = F.WS; \
          pg8::EpiGate<1> E{F.GB, F.MG}; \
          pg8::gemm_phase<pg8::EpiGate<1>, pg8::ChainOrder, PG8_ALIGN, PG8_SP2>(F.lds + RING_OFF, g, S, E); } \
        if (BOTH(8)) GRID_BAR(); } } while (0)
#define PH9(LAST) do { if (IN(9)) { \
        pg8::Gemm g{F.MG, F.WO, M, D, D}; pg8::StaticOrder S; S.init(M, D, F.G, (int)blockIdx.x); \
        pg8::EpiOut E{F.x, F.MOD + 2048, F.b_ada + 2048, F.out}; \
        pg8::gemm_phase<pg8::EpiOut, pg8::StaticOrder, PG8_ALIGN, PG8_SP2>(F.lds + RING_OFF, g, S, E); \
        if (!(LAST)) GRID_BAR(); } } while (0)
#ifndef REP
#define REP 0
#endif
#ifdef TPROBE
    unsigned long long tp0 = 0, tp1 = 0;
#define TP(k, X) do { if ((k) == TPROBE) tp0 = rt(); X; if ((k) == TPROBE) tp1 = rt(); } while (0)
#else
#define TP(k, X) do { X; } while (0)
#endif
    TP(0, PH0()); TP(1, PH1()); TP(2, PH2()); TP(3, PH3()); TP(4, PH4()); TP(5, PH5()); TP(6, PH6()); TP(7, PH7()); TP(8, PH8()); TP(9, PH9(true));
#ifdef TPROBE
    if (blockIdx.x == 0) { const unsigned long long need = (tp1 - tp0) * 8ull, s0 = rt(); while (rt() - s0 < need) __builtin_amdgcn_s_sleep(20); }
#endif
#undef IN
#undef BOTH
}

extern "C" void kernel_launch(void* const* d_in, const int* in_sizes, int n_in, void* d_out, int out_size, void* d_ws, size_t ws_size, hipStream_t stream) {
    static int grid = 0;
    if (grid == 0) {
        if (n_in != 19 || in_sizes[0] != M * D || out_size != M * D || ws_size < WS_END) { fprintf(stderr, "kernel_launch: unexpected shapes (n_in %d, in0 %d, out %d, ws %zu); nothing launched\n", n_in, n_in > 0 ? in_sizes[0] : -1, out_size, ws_size); grid = -1; return; }
        int dev = 0, cus = 0, per_cu = 0;
        if (hipGetDevice(&dev) != hipSuccess || hipDeviceGetAttribute(&cus, hipDeviceAttributeMultiprocessorCount, dev) != hipSuccess) { grid = -1; return; }
        if (hipFuncSetAttribute((const void*)mk_fwd, hipFuncAttributeMaxDynamicSharedMemorySize, LDS_BYTES) != hipSuccess) { fprintf(stderr, "kernel_launch: hipFuncSetAttribute failed\n"); grid = -1; return; }
        if (hipOccupancyMaxActiveBlocksPerMultiprocessor(&per_cu, (const void*)mk_fwd, NWAVES * 64, LDS_BYTES) != hipSuccess || per_cu < 1) { fprintf(stderr, "kernel_launch: occupancy query says %d blocks/CU\n", per_cu); }
        (void)hipGetLastError();
        grid = cus;
    }
    if (grid < 0) return;
    (void)hipMemsetAsync((char*)d_ws + WS_CTL, 0, CTL_ZERO_BYTES, stream);
    (void)hipMemsetAsync((char*)d_ws + WS_MISC, 0, 2 * 3072 * sizeof(float), stream);
    Args a{};
    for (int i = 0; i < 19; ++i) a.in[i] = (const float*)d_in[i];
    a.out = (float*)d_out; a.ws = (unsigned char*)d_ws;
    for (int li = 0; li < N_LAUNCHES; ++li) {
        a.ph_lo = (N_LAUNCHES == PER_PHASE) ? li : 0; a.ph_hi = (N_LAUNCHES == PER_PHASE) ? li + 1 : PER_PHASE; a.li = li;
        hipLaunchKernelGGL(mk_fwd, dim3(grid), dim3(NWAVES * 64), LDS_BYTES, stream, a);
    }
}
```

```cpp
#include <hip/hip_runtime.h>
#include <cstdio>
#include <cstdint>
#include <cmath>
namespace pg8 {
#define PG8_LAS __attribute__((address_space(3)))
typedef unsigned short bf16_t;
typedef short bf16x8 __attribute__((ext_vector_type(8)));
typedef float f32x4 __attribute__((ext_vector_type(4)));
typedef unsigned u32x4 __attribute__((ext_vector_type(4)));
constexpr int BM = 256, BK = 64, HALF = 128, HTB = HALF * BK * 2  , STAGE_BYTES = 8 * HTB, NXCD = 8, WGM = 8;

__host__ __device__ __forceinline__ int lds_byte(int r, int c) { const int st = (r >> 4) * 2 + (c >> 5), rr = r & 15, cc = c & 31, ob = rr * 64 + cc * 2; return st * 1024 + (ob ^ (((ob >> 9) & 1) << 5)); }
__host__ __device__ __forceinline__ void stage_rc(int b, int& R, int& C) { const int st = b / 1024, sb = b % 1024, swz = sb ^ (((sb >> 9) & 1) << 5); R = (st >> 1) * 16 + swz / 64; C = (st & 1) * 32 + (swz % 64) / 2; }
__host__ __device__ __forceinline__ int perm32(int rho) { const int n = rho >> 4, i = rho & 15; return 8 * (i >> 2) + 4 * n + (i & 3); }

struct Unit { int pm, pn; const bf16_t* A = nullptr; const bf16_t* B = nullptr; int mode = 0; int chain = 0; };
struct Gemm { const bf16_t* A; const bf16_t* Bt; int M, N, K; };

struct StaticOrder {
    int nM, nN, nwg, G, c;
    __host__ __device__ void init(int M, int N, int G_, int c_) { nM = M / BM; nN = N / BM; nwg = nM * nN; G = G_; c = c_; }
    __host__ __device__ bool next(int i, Unit& u) const {
        const long L = (long)i * G + c; if (L >= nwg) return false;
        int wgid = (int)L; { const int q = nwg / NXCD, r = nwg % NXCD, xcd = wgid % NXCD, off = wgid / NXCD; wgid = (xcd < r ? xcd * (q + 1) : r * (q + 1) + (xcd - r) * q) + off; }
        const int nig = WGM * nN, gid = wgid / nig, fm = gid * WGM, gsz = (nM - fm) < WGM ? (nM - fm) : WGM;
        u.pm = fm + ((wgid % nig) % gsz); u.pn = (wgid % nig) / gsz; return true;
    }
    __device__ __forceinline__ void a_ready(const Unit&) const {}
    __device__ __forceinline__ void done(const Unit&) const {}
};

__device__ __forceinline__ unsigned cvt_pk_bf16(float lo, float hi) { unsigned r; asm volatile("v_cvt_pk_bf16_f32 %0, %1, %2" : "=v"(r) : "v"(lo), "v"(hi)); return r; }
__device__ __forceinline__ float sigm(float v) { return __builtin_amdgcn_rcpf(1.f + __builtin_amdgcn_exp2f(-1.4426950408889634f * v)); }
__device__ __forceinline__ float bflo(unsigned w) { return __uint_as_float(w << 16); }
__device__ __forceinline__ float bfhi(unsigned w) { return __uint_as_float(w & 0xffff0000u); }

__device__ __forceinline__ float softplus_f(float x) {
    const float e = __builtin_amdgcn_exp2f(-1.4426950408889634f * __builtin_fabsf(x));
    const float ser = e * (1.f + e * (-0.5f + e * (0.33333334f - 0.25f * e)));
    const float lg = 0.6931471805599453f * __builtin_amdgcn_logf(1.f + e);
    return __builtin_fmaxf(x, 0.f) + (e < 0.015625f ? ser : lg);
}

struct EpiInProj {
    static constexpr bool PERM = true, AFTER_DRAIN = false;
    bf16_t *Q, *Kb, *Vb, *ZA, *ZM, *XBC, *GA, *GB; float* DT; const float* dt_bias; int tile_off; bf16_t* HALO;
    __device__ __forceinline__ void operator()(const f32x4 (&acc)[2][2][4][2], const Unit& u, int wr, int wc, int fr, int fq) const {
        const int pn = u.pn + tile_off;
        const int row0 = u.pm * BM + wr * 64 + fr;
        if (pn == 30) {
            if (wc == 0) {
                const int c = 8 * fq;
                const f32x4 b0 = *(const f32x4*)(dt_bias + c), b1 = *(const f32x4*)(dt_bias + c + 4);
#pragma unroll
                for (int ai = 0; ai < 2; ++ai)
#pragma unroll
                    for (int m = 0; m < 4; ++m) {
                        const int r = row0 + ai * HALF + m * 16;
                        float* rp = DT + ((size_t)(r >> 7) * 32 + c) * 128 + (r & 127);
                        f32x4 v0 = acc[ai][0][m][0] + b0, v1 = acc[ai][0][m][1] + b1;
#pragma unroll
                        for (int j = 0; j < 4; ++j) { v0[j] = softplus_f(v0[j]); v1[j] = softplus_f(v1[j]); }
#pragma unroll
                        for (int j = 0; j < 4; ++j) { rp[j * 128] = v0[j]; rp[(4 + j) * 128] = v1[j]; }
                    }
            }
            return;
        }
        bf16_t* base; int ldc, c0, act;
        if (pn < 4) { base = Q; ldc = 1024; c0 = pn * 256; act = 0; }
        else if (pn == 4) { base = Kb; ldc = 256; c0 = 0; act = 0; }
        else if (pn == 5) { base = Vb; ldc = 256; c0 = 0; act = 0; }
        else if (pn < 10) { base = ZA; ldc = 1024; c0 = (pn - 6) * 256; act = 1; }
        else if (pn < 18) { base = ZM + (pn >= 14 ? (size_t)16384 * 1024 : 0); ldc = 1024; c0 = ((pn - 10) & 3) * 256; act = 1; }
        else if (pn < 30) { base = XBC; ldc = 3072; c0 = (pn - 18) * 256; act = 0; }
        else if (pn < 35) { base = GA; ldc = 1024; c0 = (pn - 31) * 256; act = 2; }
        else { base = GB; ldc = 1024; c0 = (pn - 35) * 256; act = 2; }
        const int col0 = c0 + wc * 32 + 8 * fq;
#pragma unroll
        for (int ai = 0; ai < 2; ++ai)
#pragma unroll
            for (int m = 0; m < 4; ++m) { bf16_t* rowp = base + (size_t)(row0 + ai * HALF + m * 16) * ldc + col0;
#pragma unroll
                for (int bj = 0; bj < 2; ++bj) { f32x4 v0 = acc[ai][bj][m][0], v1 = acc[ai][bj][m][1];
                    if (act == 1) {
#pragma unroll
                        for (int j = 0; j < 4; ++j) { v0[j] = v0[j] * sigm(v0[j]); v1[j] = v1[j] * sigm(v1[j]); } }
                    else if (act == 2) {
#pragma unroll
                        for (int j = 0; j < 4; ++j) { v0[j] = sigm(v0[j]); v1[j] = sigm(v1[j]); } }
                    u32x4 w; w.x = cvt_pk_bf16(v0[0], v0[1]); w.y = cvt_pk_bf16(v0[2], v0[3]); w.z = cvt_pk_bf16(v1[0], v1[1]); w.w = cvt_pk_bf16(v1[2], v1[3]);
                    *(u32x4*)(rowp + bj * HALF) = w;
                    if (pn >= 18 && pn < 26 && wr == 1 && m == 3 && fr >= 13) {
                        const int r = row0 + ai * HALF + m * 16;
                        *(u32x4*)(HALO + ((size_t)(r >> 7) * 3 + (fr - 13)) * 2048 + col0 + bj * HALF) = w; } } }
    }
};

template <int MODE> struct EpiGate {
    static constexpr bool PERM = true, AFTER_DRAIN = false;
    const bf16_t* G; bf16_t* O;
    __device__ __forceinline__ void operator()(const f32x4 (&acc)[2][2][4][2], const Unit& u, int wr, int wc, int fr, int fq) const {
        const int row0 = u.pm * BM + wr * 64 + fr, col0 = u.pn * BM + wc * 32 + 8 * fq;
#pragma unroll
        for (int ai = 0; ai < 2; ++ai)
#pragma unroll
            for (int m = 0; m < 4; ++m) { const size_t off = (size_t)(row0 + ai * HALF + m * 16) * 1024 + col0;
#pragma unroll
                for (int bj = 0; bj < 2; ++bj) { const f32x4 v0 = acc[ai][bj][m][0], v1 = acc[ai][bj][m][1];
                    const u32x4 g = *(const u32x4*)(G + off + bj * HALF);
                    float r[8];
                    r[0] = bflo(g.x) * v0[0]; r[1] = bfhi(g.x) * v0[1]; r[2] = bflo(g.y) * v0[2]; r[3] = bfhi(g.y) * v0[3];
                    r[4] = bflo(g.z) * v1[0]; r[5] = bfhi(g.z) * v1[1]; r[6] = bflo(g.w) * v1[2]; r[7] = bfhi(g.w) * v1[3];
                    if (MODE == 1) { const u32x4 o = *(const u32x4*)(O + off + bj * HALF);
                        r[0] += bflo(o.x); r[1] += bfhi(o.x); r[2] += bflo(o.y); r[3] += bfhi(o.y); r[4] += bflo(o.z); r[5] += bfhi(o.z); r[6] += bflo(o.w); r[7] += bfhi(o.w); }
                    u32x4 w; w.x = cvt_pk_bf16(r[0], r[1]); w.y = cvt_pk_bf16(r[2], r[3]); w.z = cvt_pk_bf16(r[4], r[5]); w.w = cvt_pk_bf16(r[6], r[7]);
                    *(u32x4*)(O + off + bj * HALF) = w; } }
    }
};

struct EpiOut {
    static constexpr bool PERM = false, AFTER_DRAIN = false;
    const float* x; const float* gate; const float* gbias; float* out;
    __device__ __forceinline__ void operator()(const f32x4 (&acc)[2][2][4][2], const Unit& u, int wr, int wc, int fr, int fq) const {
        const int row0 = u.pm * BM + wr * 64 + fr, col0 = u.pn * BM + wc * 32 + 4 * fq;
        const float* gb = gate + (size_t)((u.pm * BM) >> 13) * 3072;
#pragma unroll
        for (int bj = 0; bj < 2; ++bj)
#pragma unroll
            for (int n = 0; n < 2; ++n) { const int c = col0 + bj * HALF + n * 16; f32x4 gv = *(const f32x4*)(gbias + c);
#pragma unroll
                for (int k = 0; k < 4; ++k) gv[k] += __hip_atomic_load(gb + c + k, __ATOMIC_RELAXED, __HIP_MEMORY_SCOPE_AGENT);
#pragma unroll
                for (int ai = 0; ai < 2; ++ai)
#pragma unroll
                    for (int m = 0; m < 4; ++m) { const size_t off = (size_t)(row0 + ai * HALF + m * 16) * 1024 + c;
                        const f32x4 xv = *(const f32x4*)(x + off); *(f32x4*)(out + off) = xv + gv * acc[ai][bj][m][n]; } }
    }
};


struct ChainOrder {
    StaticOrder base; const bf16_t *ZM, *WS;
    __device__ bool next(int i, Unit& u) const {
        if (i >= 2) return false;
        if (!base.next(0, u)) return false;
        if (i == 0) { u.A = ZM; u.B = WS; u.mode = 3; u.chain = 1; }
        else { u.A = ZM + (size_t)16384 * 1024; u.B = WS + (size_t)1024 * 1024; u.mode = 4; u.chain = 0; }
        return true;
    }
    __device__ __forceinline__ void a_ready(const Unit&) const {}
    __device__ __forceinline__ void done(const Unit&) const {}
};

struct PairOrder {
    StaticOrder base;
    __device__ bool next(int i, Unit& u) const { if (i >= 2) return false; if (!base.next(0, u)) return false; u.pn += 4 * i; return true; }
    __device__ __forceinline__ void a_ready(const Unit&) const {}
    __device__ __forceinline__ void done(const Unit&) const {}
};
template <class Epi, class Sched, bool ALIGN_EPI = false, bool SP2 = false>
__device__ __forceinline__ void gemm_phase(PG8_LAS unsigned char* lds, const Gemm g, const Sched& S, const Epi& E) {
    const int tid = threadIdx.x, wid = __builtin_amdgcn_readfirstlane(tid >> 6), lane = tid & 63, wr = wid >> 2, wc = wid & 3, fr = lane & 15, fq = lane >> 4;
    const int K = g.K, nt = K / BK;
    unsigned voffA[2], voffB[2];
#pragma unroll
    for (int i = 0; i < 2; ++i) { int R, C; stage_rc(tid * 16 + i * 8192, R, C); const int Rb = Epi::PERM ? ((R & ~31) + perm32(R & 31)) : R;
        voffA[i] = (unsigned)(R * K + C) * 2u; voffB[i] = (unsigned)(Rb * K + C) * 2u; }
    const size_t kstep = (size_t)(BK * 2);
    const size_t hstep = (size_t)HALF * K * 2;
    const size_t tstep = 2 * hstep;
    const unsigned ldsw = (unsigned)wid * 1024u;
    const int aoff = lds_byte(wr * 64 + fr, fq * 8), boff = lds_byte(wc * 32 + fr, fq * 8);
#define PG8_SA(b, h) (((b) * 2 + (h)) * HTB)
#define PG8_SB(b, h) ((4 + (b) * 2 + (h)) * HTB)
#define PG8_STAGE(bufoff, gbase, voff) do { _Pragma("unroll") for (int _i = 0; _i < 2; ++_i) \
        __builtin_amdgcn_global_load_lds((const unsigned*)((const char*)(gbase) + (voff)[_i]), (PG8_LAS unsigned*)(lds + (bufoff) + ldsw + _i * 8192), 16, 0, 0); } while (0)
#define PG8_LDA(dst, b, h) do { _Pragma("unroll") for (int m = 0; m < 4; ++m) _Pragma("unroll") for (int k = 0; k < 2; ++k) dst[m][k] = *(const PG8_LAS bf16x8*)(lds + PG8_SA(b, h) + aoff + m * 2048 + k * 1024); } while (0)
#define PG8_LDB(dst, b, h) do { _Pragma("unroll") for (int n = 0; n < 2; ++n) _Pragma("unroll") for (int k = 0; k < 2; ++k) dst[n][k] = *(const PG8_LAS bf16x8*)(lds + PG8_SB(b, h) + boff + n * 2048 + k * 1024); } while (0)
#define PG8_MMA(ai, bj, At, Bt) do { __builtin_amdgcn_s_setprio(1); _Pragma("unroll") for (int m = 0; m < 4; ++m) _Pragma("unroll") for (int n = 0; n < 2; ++n) _Pragma("unroll") for (int k = 0; k < 2; ++k) \
        acc[ai][bj][m][n] = __builtin_amdgcn_mfma_f32_16x16x32_bf16(Bt[n][k], At[m][k], acc[ai][bj][m][n], 0, 0, 0); __builtin_amdgcn_s_setprio(0); } while (0)
#define PG8_WAIT_V(n) asm volatile("s_waitcnt vmcnt(" #n ")" ::: "memory")
#define PG8_WAIT_L(n) asm volatile("s_waitcnt lgkmcnt(" #n ")" ::: "memory")
#define PG8_BAR do { __builtin_amdgcn_s_barrier(); asm volatile("" ::: "memory"); } while (0)
#define PG8_SCHED __builtin_amdgcn_sched_barrier(0)
    Unit cur, nxt; int ui = 0;
    if (!S.next(0, cur)) return;
    f32x4 acc[2][2][4][2];
#pragma unroll
    for (int a = 0; a < 2; ++a)
#pragma unroll
        for (int b = 0; b < 2; ++b)
#pragma unroll
            for (int m = 0; m < 4; ++m)
#pragma unroll
                for (int n = 0; n < 2; ++n) acc[a][b][m][n] = (f32x4){0.f, 0.f, 0.f, 0.f};
    bf16x8 At[4][2], B0[2][2], B1[2][2];
    const char* cA = (const char*)(cur.A ? cur.A : g.A) + (size_t)cur.pm * tstep; const char* cB = (const char*)(cur.B ? cur.B : g.Bt) + (size_t)cur.pn * tstep;
    S.a_ready(cur);
    if constexpr (SP2) {
        PG8_STAGE(PG8_SB(0, 0), cB, voffB); PG8_STAGE(PG8_SB(0, 1), cB + hstep, voffB); PG8_STAGE(PG8_SA(0, 0), cA, voffA); PG8_STAGE(PG8_SA(0, 1), cA + hstep, voffA);
        if (wr == 1) PG8_BAR;
        PG8_WAIT_V(2); PG8_BAR;
        PG8_STAGE(PG8_SB(1, 0), cB + kstep, voffB); PG8_STAGE(PG8_SA(1, 0), cA + kstep, voffA); PG8_STAGE(PG8_SB(1, 1), cB + hstep + kstep, voffB);
        PG8_WAIT_V(6); PG8_BAR;
    } else {
        PG8_STAGE(PG8_SB(0, 0), cB, voffB); PG8_STAGE(PG8_SA(0, 0), cA, voffA); PG8_STAGE(PG8_SB(0, 1), cB + hstep, voffB); PG8_STAGE(PG8_SA(0, 1), cA + hstep, voffA);
        if (wr == 1) PG8_BAR;
        PG8_WAIT_V(4); PG8_BAR;
        PG8_STAGE(PG8_SB(1, 0), cB + kstep, voffB); PG8_STAGE(PG8_SA(1, 0), cA + kstep, voffA); PG8_STAGE(PG8_SB(1, 1), cB + hstep + kstep, voffB);
        PG8_WAIT_V(6); PG8_BAR;
    }
    for (;;) {
        const bool has_next = S.next(ui + 1, nxt);
        const char* nA = has_next ? (const char*)(nxt.A ? nxt.A : g.A) + (size_t)nxt.pm * tstep : cA; const char* nB = has_next ? (const char*)(nxt.B ? nxt.B : g.Bt) + (size_t)nxt.pn * tstep : cB;
        for (int t = 0; t < nt; t += 2) {
            const bool last = (t == nt - 2);
            const char* a1 = cA + (size_t)(t + 1) * kstep;
            const char* a2 = last ? nA : cA + (size_t)(t + 2) * kstep; const char* b2 = last ? nB : cB + (size_t)(t + 2) * kstep;
            const char* a3 = a2 + kstep; const char* b3 = b2 + kstep;
            if (last && has_next) S.a_ready(nxt);
            if constexpr (SP2) {
            PG8_LDB(B0, 0, 0); PG8_LDB(B1, 0, 1); PG8_SCHED; PG8_LDA(At, 0, 0); PG8_STAGE(PG8_SA(1, 1), a1 + hstep, voffA);
            PG8_WAIT_V(8); PG8_WAIT_L(0); PG8_BAR; PG8_MMA(0, 0, At, B0); PG8_MMA(0, 1, At, B1); PG8_BAR; PG8_SCHED;
            PG8_LDA(At, 0, 1); PG8_STAGE(PG8_SB(0, 0), b2, voffB); PG8_STAGE(PG8_SB(0, 1), b2 + hstep, voffB); PG8_STAGE(PG8_SA(0, 0), a2, voffA);
            PG8_WAIT_V(8); PG8_WAIT_L(0); PG8_BAR; PG8_MMA(1, 0, At, B0); PG8_MMA(1, 1, At, B1); PG8_BAR; PG8_SCHED;
            PG8_LDB(B0, 1, 0); PG8_LDB(B1, 1, 1); PG8_SCHED; PG8_LDA(At, 1, 0); PG8_STAGE(PG8_SA(0, 1), a2 + hstep, voffA);
            PG8_WAIT_V(8); PG8_WAIT_L(0); PG8_BAR; PG8_MMA(0, 0, At, B0); PG8_MMA(0, 1, At, B1); PG8_BAR; PG8_SCHED;
            PG8_LDA(At, 1, 1); PG8_STAGE(PG8_SB(1, 0), b3, voffB); PG8_STAGE(PG8_SB(1, 1), b3 + hstep, voffB); PG8_STAGE(PG8_SA(1, 0), a3, voffA);
            PG8_WAIT_V(8); PG8_WAIT_L(0); PG8_BAR; PG8_MMA(1, 0, At, B0); PG8_MMA(1, 1, At, B1); PG8_BAR; PG8_SCHED;
            } else {
            PG8_LDB(B0, 0, 0); PG8_SCHED; PG8_LDA(At, 0, 0); PG8_STAGE(PG8_SA(1, 1), a1 + hstep, voffA);
            PG8_WAIT_L(8); PG8_BAR; PG8_WAIT_L(0); PG8_MMA(0, 0, At, B0); PG8_BAR; PG8_SCHED;
            PG8_LDB(B1, 0, 1); PG8_STAGE(PG8_SB(0, 0), b2, voffB);
            PG8_BAR; PG8_WAIT_L(0); PG8_MMA(0, 1, At, B1); PG8_BAR;
            PG8_LDA(At, 0, 1); PG8_STAGE(PG8_SA(0, 0), a2, voffA);
            PG8_BAR; PG8_WAIT_L(0); PG8_MMA(1, 0, At, B0); PG8_BAR; PG8_SCHED;
            PG8_STAGE(PG8_SB(0, 1), b2 + hstep, voffB);
            PG8_WAIT_V(6); PG8_BAR; PG8_MMA(1, 1, At, B1); PG8_BAR;
            PG8_LDB(B0, 1, 0); PG8_SCHED; PG8_LDA(At, 1, 0); PG8_STAGE(PG8_SA(0, 1), a2 + hstep, voffA);
            PG8_WAIT_L(8); PG8_BAR; PG8_WAIT_L(0); PG8_MMA(0, 0, At, B0); PG8_BAR; PG8_SCHED;
            PG8_LDB(B1, 1, 1); PG8_STAGE(PG8_SB(1, 0), b3, voffB);
            PG8_BAR; PG8_WAIT_L(0); PG8_MMA(0, 1, At, B1); PG8_BAR;
            PG8_LDA(At, 1, 1); PG8_STAGE(PG8_SA(1, 0), a3, voffA);
            PG8_BAR; PG8_WAIT_L(0); PG8_MMA(1, 0, At, B0); PG8_BAR; PG8_SCHED;
            PG8_STAGE(PG8_SB(1, 1), b3 + hstep, voffB);
            PG8_WAIT_V(6); PG8_BAR; PG8_MMA(1, 1, At, B1); PG8_BAR;
            }
        }
        if constexpr (ALIGN_EPI) { if (wr == 0) PG8_BAR; }
        if constexpr (!Epi::AFTER_DRAIN) { if (!cur.chain) E(acc, cur, wr, wc, fr, fq); S.done(cur); }
        if (!has_next) break;
        if (!cur.chain)
#pragma unroll
        for (int a = 0; a < 2; ++a)
#pragma unroll
            for (int b = 0; b < 2; ++b)
#pragma unroll
                for (int m = 0; m < 4; ++m)
#pragma unroll
                    for (int n = 0; n < 2; ++n) acc[a][b][m][n] = (f32x4){0.f, 0.f, 0.f, 0.f};
        cur = nxt; cA = nA; cB = nB; ++ui;
        if constexpr (ALIGN_EPI) { if (wr == 1) PG8_BAR; }
    }
    PG8_WAIT_V(0);
    if constexpr (!ALIGN_EPI) { if (wr == 0) PG8_BAR; }
    PG8_BAR;
    if constexpr (Epi::AFTER_DRAIN) { E.fused(acc, cur, wr, wc, fr, fq, lds, wid, lane); S.done(cur); }
#undef PG8_SA
#undef PG8_SB
#undef PG8_STAGE
#undef PG8_LDA
#undef PG8_LDB
#undef PG8_MMA
#undef PG8_WAIT_V
#undef PG8_WAIT_L
#undef PG8_BAR
#undef PG8_SCHED
}
}

#ifndef PG8_SP2
#define PG8_SP2 true
#endif
#ifndef PG8_ALIGN
#define PG8_ALIGN true
#endif
constexpr int NWAVES = 8;
#ifndef MK_N_LAUNCHES
#define MK_N_LAUNCHES 1
#endif
constexpr int PER_PHASE = 10;
constexpr int N_LAUNCHES = MK_N_LAUNCHES;

constexpr int BATCH = 2, SEQ = 8192, D = 1024, M = BATCH * SEQ;
constexpr int NHEAD = 16, NKV = 4, HD = 64;
constexpr int SSMW = 2048, SH = 32, SG = 4, SR = 8, SP = 64, SN = 128, XBCW = 3072, CH = 128, NCH = SEQ / CH;
constexpr int IN_W = 9760, N_MAIN = 31 * 256, N_GATE = 2048, N_INT = N_MAIN + N_GATE;
constexpr float EPS = 1e-6f;

constexpr size_t MiB = 1u << 20;
constexpr size_t WS_CTL = 0, CTL_ZERO_BYTES = 64 * 1024;
constexpr size_t WS_WIN = 64 * 1024;
constexpr size_t WS_WA = WS_WIN + (size_t)N_INT * D * 2;
constexpr size_t WS_WS = WS_WA + 2 * MiB;
constexpr size_t WS_WO = WS_WS + 4 * MiB;
constexpr size_t WS_MISC = WS_WO + 2 * MiB;
constexpr size_t WS_DT = WS_MISC + 64 * 1024;
constexpr size_t WS_HALO = WS_DT + 2 * MiB;
constexpr size_t WS_XN = 32 * MiB;
constexpr size_t WS_Q = 64 * MiB;
constexpr size_t WS_ZM = 96 * MiB;
constexpr size_t WS_XBC = 160 * MiB;
constexpr size_t WS_GA = 160 * MiB, WS_GB = 192 * MiB, WS_MG = 224 * MiB, WS_END = 256 * MiB;
static_assert(WS_HALO + (size_t)(M / 128) * 3 * 2048 * 2 <= WS_XN, "ws map");
constexpr size_t OUT_K = 0, OUT_V = 8 * MiB, OUT_ZA = 16 * MiB, OUT_ST = 0;

constexpr int CW_MODCNT = 64;
constexpr int CW_BAR = 4096;

constexpr int RING_OFF = 0, RING_BYTES = 131072;
constexpr int LDSCTL_OFF = RING_BYTES, MISC_OFF = LDSCTL_OFF + 320;
constexpr int SMALL_OFF = RING_BYTES + 1024;
constexpr int LDS_BYTES = 147456;

#define GAS __attribute__((address_space(1)))
#define LAS __attribute__((address_space(3)))
typedef unsigned short bf16;
typedef unsigned v4u __attribute__((ext_vector_type(4)));
typedef float f32x4 __attribute__((ext_vector_type(4)));
typedef short bf16x8 __attribute__((ext_vector_type(8)));
typedef GAS unsigned gu32;
typedef GAS unsigned long long gu64;
#define RLX_AGENT __ATOMIC_RELAXED, __HIP_MEMORY_SCOPE_AGENT
#define LDS_WAIT() asm volatile("s_waitcnt lgkmcnt(0)" ::: "memory")
#define VM_WAIT() asm volatile("s_waitcnt vmcnt(0)" ::: "memory")
__device__ __forceinline__ unsigned long long rt() { return __builtin_amdgcn_s_memrealtime(); }
__device__ __forceinline__ unsigned f2bf(float f) { unsigned u = __builtin_bit_cast(unsigned, f); return (u + 0x7fffu + ((u >> 16) & 1u)) >> 16; }
__device__ __forceinline__ unsigned pk2(float lo, float hi) { return f2bf(lo) | (f2bf(hi) << 16); }

#define XB_TMO      128
#define XB_XCNT(j)  (256  + 64 * (j))
#define XB_XSUB(j)  (1280 + 64 * (j))
#define XB_XGEN(j)  (2304 + 64 * (j))
#define XB_TOP      3328
#define XB_TOPGEN   3392
#define XCD_BAR_WORDS 3456
#define XB_SPIN_CAP (1u << 18)

__device__ __forceinline__ unsigned xb_ld(unsigned* p)              { return __hip_atomic_load(p, __ATOMIC_RELAXED, __HIP_MEMORY_SCOPE_AGENT); }
__device__ __forceinline__ unsigned xb_add(unsigned* p, unsigned v) { return __hip_atomic_fetch_add(p, v, __ATOMIC_RELAXED, __HIP_MEMORY_SCOPE_AGENT); }
__device__ __forceinline__ unsigned xb_xcc_id() { return (unsigned)__builtin_amdgcn_s_getreg((3 << 11) | 20) & 0xFu; }
#define XB_SPIN(cond, bar) do { unsigned _sp = 0; while (cond) { __builtin_amdgcn_s_sleep(1); \
    if ((++_sp & 255u) == 0u) { if (xb_ld(&(bar)[XB_TMO])) break; if (_sp > XB_SPIN_CAP) { atomicAdd(&(bar)[XB_TMO], 1u); break; } } } } while (0)

struct XcdBarrier {
    unsigned* bar; unsigned x;
    volatile LAS unsigned* st;
};

__device__ __forceinline__ XcdBarrier xcd_barrier_post(unsigned* bar, volatile LAS unsigned* st) {
    XcdBarrier b; b.bar = bar; b.x = xb_xcc_id(); b.st = st;
    if (threadIdx.x == 0) (void)xb_add(&bar[XB_XCNT(b.x)], 1u);
    return b;
}
__device__ __forceinline__ void xcd_barrier_complete(unsigned* bar, unsigned x, unsigned& nloc, unsigned& nx) {
    const unsigned G = gridDim.x * gridDim.y * gridDim.z;
    unsigned sum, cnt, mine, sp = 0u;
    for (;;) {
        sum = 0u; cnt = 0u; mine = 0u;
#pragma unroll
        for (unsigned j = 0; j < 16; ++j) { const unsigned c = xb_ld(&bar[XB_XCNT(j)]); sum += c; cnt += (c > 0u) ? 1u : 0u; mine = (j == x) ? c : mine; }
        if (sum == G) break;
        __builtin_amdgcn_s_sleep(1);
        if ((++sp & 255u) == 0u) { if (xb_ld(&bar[XB_TMO])) break; if (sp > XB_SPIN_CAP) { atomicAdd(&bar[XB_TMO], 1u); break; } }
    }
    nloc = mine > 0u ? mine : 1u; nx = cnt > 0u ? cnt : 1u;
}

__device__ __forceinline__ void xcd_barrier(const XcdBarrier& b) {
    asm volatile("s_waitcnt vmcnt(0)" ::: "memory");
    __syncthreads();
    if (threadIdx.x == 0) {
        unsigned* bar = b.bar;
        __builtin_amdgcn_s_waitcnt(0);
        unsigned nloc = b.st[0], nx = b.st[1];
        if (nloc == 0u) { xcd_barrier_complete(bar, b.x, nloc, nx); b.st[0] = nloc; b.st[1] = nx; }
        const unsigned old = xb_add(&bar[XB_XSUB(b.x)], 1u);
        const unsigned gen = old / nloc;
        if (old + 1u == (gen + 1u) * nloc) {
            __builtin_amdgcn_fence(__ATOMIC_RELEASE, "agent");
            asm volatile("s_waitcnt vmcnt(0)" ::: "memory");
            const unsigned og = xb_add(&bar[XB_TOP], 1u);
            const unsigned tg = og / nx;
            if (og + 1u == (tg + 1u) * nx) xb_add(&bar[XB_TOPGEN], 1u);
            else XB_SPIN(xb_ld(&bar[XB_TOPGEN]) == tg, bar);
            __builtin_amdgcn_fence(__ATOMIC_ACQUIRE, "agent");
            xb_add(&bar[XB_XGEN(b.x)], 1u);
            asm volatile("s_waitcnt vmcnt(0)" ::: "memory");
        } else {
            XB_SPIN(xb_ld(&bar[XB_XGEN(b.x)]) == gen, bar);
            __builtin_amdgcn_fence(__ATOMIC_ACQUIRE, "agent");
            asm volatile("s_waitcnt vmcnt(0)" ::: "memory");
        }
    }
    __syncthreads();
}

struct Frame {
    LAS unsigned char* lds;
    volatile LAS unsigned* MISC;
    gu32* ctl;
    int tid, lane, wave;
    int vcu, G;
    const float *x, *c, *w_ada, *b_ada, *norm_w, *w_in, *q_norm_w, *k_norm_w, *rel_bias, *sinks, *conv_w, *conv_b, *dt_bias, *a_log, *d_skip, *ssm_norm_w, *w_attn, *w_ssm, *w_out;
    float* out;
    bf16 *WIN, *WA, *WS, *WO, *XN, *Q, *KB, *VB, *ZA, *ZM, *XBC, *GA, *GB, *MG, *ST, *HALO;
    float *MOD, *CDEC, *DT;
};

__device__ __forceinline__ float wave_sum(float v) {
#pragma unroll
    for (int o = 1; o < 64; o <<= 1) v += __shfl_xor(v, o);
    return v;
}
__device__ __forceinline__ float bf2f(bf16 v) { return __uint_as_float((unsigned)v << 16); }
__device__ __forceinline__ float blo(unsigned w) { return __uint_as_float(w << 16); }
__device__ __forceinline__ float bhi(unsigned w) { return __uint_as_float(w & 0xffff0000u); }
__device__ __forceinline__ float silu_f(float v) { return v / (1.f + __expf(-v)); }
__device__ __forceinline__ int t5_bucket(int n) {
    if (n < 16) return n;
    const int l = 16 + (int)(log2f((float)n * 0.0625f) * (16.0f / 3.0f));
    return l < 31 ? l : 31;
}

typedef short s16x4_ __attribute__((ext_vector_type(4)));
struct P0Item { const float* W; int K, N, row_off, Kd; bf16* WT; int item; };
__device__ __forceinline__ void p0_item_load(const P0Item& it, int lane, f32x4 (&v)[8]) {
    const int nblk = it.N / 32, kb = it.item / nblk, nb = it.item % nblk, k0 = 64 * kb, n0 = 32 * nb;
    const float* src = it.W + (size_t)(k0 + (lane >> 3)) * it.N + n0 + 4 * (lane & 7);
#pragma unroll
    for (int i = 0; i < 8; ++i) v[i] = __builtin_nontemporal_load((const GAS f32x4*)(src + (size_t)(8 * i) * it.N));
}
__device__ __forceinline__ void p0_item_finish(const P0Item& it, int lane, const f32x4 (&v)[8], LAS unsigned char* scr) {
    const int nblk = it.N / 32, kb = it.item / nblk, nb = it.item % nblk, k0 = 64 * kb, n0 = 32 * nb;
#pragma unroll
    for (int i = 0; i < 8; ++i) { unsigned long long w = (unsigned long long)pk2(v[i].x, v[i].y) | ((unsigned long long)pk2(v[i].z, v[i].w) << 32);
        *(LAS unsigned long long*)(scr + (8 * i + (lane >> 3)) * 192 + 8 * (lane & 7)) = w; }
    LDS_WAIT(); asm volatile("" ::: "memory");
    const int h = lane >> 5, blk = (lane >> 4) & 1, q = (lane & 15) >> 2, p = lane & 3;
    const LAS unsigned char* tb = scr + (8 * h + q) * 192 + 32 * blk + 8 * p;
    const int kd = it.Kd ? it.Kd : it.K;
    bf16* dst = it.WT + (size_t)(k0 / kd) * it.N * kd + (size_t)(it.row_off + n0 + (lane & 31)) * kd + (k0 % kd) + 8 * h;
#pragma unroll
    for (int ks = 0; ks < 4; ++ks) {
        const s16x4_ lo = __builtin_bit_cast(s16x4_, __builtin_amdgcn_ds_read_tr16_b64_v4i16((LAS s16x4_*)(tb + 16 * ks * 192)));
        const s16x4_ hi = __builtin_bit_cast(s16x4_, __builtin_amdgcn_ds_read_tr16_b64_v4i16((LAS s16x4_*)(tb + (16 * ks + 4) * 192)));
        const bf16x8 o = __builtin_shufflevector(lo, hi, 0, 1, 2, 3, 4, 5, 6, 7);
        *(GAS bf16x8*)(dst + 16 * ks) = o; }
    LDS_WAIT(); asm volatile("" ::: "memory");
}

__device__ __forceinline__ void p0_prologue(Frame& F) {
    LAS unsigned char* scr = F.lds + RING_OFF + F.wave * 12288;
    const int gw = F.vcu * NWAVES + F.wave, NGW = F.G * NWAVES;
    if (F.vcu < 96) {
        const int cg = F.vcu % 12, n = cg * 256 + 4 * F.lane, k0 = (F.vcu / 12) * 128 + 16 * F.wave;
        f32x4 wv[16];
#pragma unroll
        for (int i = 0; i < 16; ++i) wv[i] = __builtin_nontemporal_load((const GAS f32x4*)(F.w_ada + (size_t)(k0 + i) * 3072 + n));
        f32x4 a0 = {0.f, 0.f, 0.f, 0.f}, a1 = {0.f, 0.f, 0.f, 0.f};
#pragma unroll
        for (int i = 0; i < 16; ++i) { const float c0 = silu_f(F.c[k0 + i]), c1 = silu_f(F.c[1024 + k0 + i]); a0 += wv[i] * c0; a1 += wv[i] * c1; }
        LAS f32x4* part = (LAS f32x4*)(F.lds + RING_OFF + 8 * 12288);
        part[(F.wave * 2 + 0) * 64 + F.lane] = a0; part[(F.wave * 2 + 1) * 64 + F.lane] = a1;
        __syncthreads();
        { const int bb = F.tid >> 8, col = F.tid & 255; float sum = 0.f;
          const LAS float* pf = (const LAS float*)part;
#pragma unroll
          for (int w8 = 0; w8 < 8; ++w8) sum += pf[((w8 * 2 + bb) * 64) * 4 + col];
          atomicAdd(F.MOD + bb * 3072 + cg * 256 + col, sum); }
        asm volatile("s_waitcnt vmcnt(0)" ::: "memory");
        __syncthreads();
        if (F.tid == 0) __hip_atomic_fetch_add(F.ctl + CW_MODCNT, 1u, __ATOMIC_RELAXED, __HIP_MEMORY_SCOPE_AGENT);
    }
    {
        GAS v4u* z = (GAS v4u*)(F.WIN + (size_t)7712 * D); const int n16 = 224 * D * 2 / 16;
        for (int i = F.vcu * 512 + F.tid; i < n16; i += F.G * 512) z[i] = (v4u){0u, 0u, 0u, 0u};
    }
    constexpr int I_IN = (D / 64) * (IN_W / 32), I_A = (D / 64) * (D / 32), I_S = (SSMW / 64) * (D / 32), I_O = I_A;
    constexpr int NITEMS = I_IN + I_A + I_S + I_O;
#define P0_DESC(it_, d_) do { int r_ = (it_); \
        if (r_ < I_IN) { d_ = P0Item{F.w_in, D, IN_W, (r_ % (IN_W / 32)) >= 241 ? 224 : 0, 0, F.WIN, r_}; } \
        else if ((r_ -= I_IN) < I_A) { d_ = P0Item{F.w_attn, D, D, 0, 0, F.WA, r_}; } \
        else if ((r_ -= I_A) < I_S) { d_ = P0Item{F.w_ssm, SSMW, D, 0, D, F.WS, r_}; } \
        else { r_ -= I_S; d_ = P0Item{F.w_out, D, D, 0, 0, F.WO, r_}; } } while (0)
    const int gwt = ((F.vcu + F.G - 96) % F.G) * NWAVES + F.wave;
    for (int it = gwt; it < I_IN; it += 2 * NGW) {
        P0Item da, db; f32x4 va[8], vb[8];
        P0_DESC(it, da); p0_item_load(da, F.lane, va);
        const bool two = it + NGW < I_IN;
        if (two) { P0_DESC(it + NGW, db); p0_item_load(db, F.lane, vb); }
        p0_item_finish(da, F.lane, va, scr);
        if (two) p0_item_finish(db, F.lane, vb, scr);
    }
}
__device__ __forceinline__ void p0_late(Frame& F, int first_wg) {
    LAS unsigned char* scr = F.lds + RING_OFF + F.wave * 12288;
    constexpr int I_IN = (D / 64) * (IN_W / 32), I_A = (D / 64) * (D / 32), I_S = (SSMW / 64) * (D / 32), I_O = I_A;
    constexpr int NITEMS = I_IN + I_A + I_S + I_O;
    const int nw = (F.G - first_wg) * NWAVES, gw = ((int)blockIdx.x - first_wg) * NWAVES + F.wave;
    for (int it = I_IN + gw; it < NITEMS; it += 2 * nw) {
        P0Item da, db; f32x4 va[8], vb[8];
        P0_DESC(it, da); p0_item_load(da, F.lane, va);
        const bool two = it + nw < NITEMS;
        if (two) { P0_DESC(it + nw, db); p0_item_load(db, F.lane, vb); }
        p0_item_finish(da, F.lane, va, scr);
        if (two) p0_item_finish(db, F.lane, vb, scr);
    }
    __syncthreads();
}
#undef P0_DESC
__device__ __forceinline__ void p0_wait_mod(Frame& F) {
    unsigned spins = 0;
    while (__hip_atomic_load(F.ctl + CW_MODCNT, __ATOMIC_RELAXED, __HIP_MEMORY_SCOPE_AGENT) < 96u) { __builtin_amdgcn_s_sleep(8); if (++spins > (1u << 22)) break; }
}

__device__ __forceinline__ void p1_norm(Frame& F) {
    const int gw = F.vcu * NWAVES + F.wave, NGW = F.G * NWAVES;
    int bcur = -1; f32x4 shv[4], scv[4], nwv[4];
    for (int m = 4 * gw; m < M; m += 4 * NGW) {
        const int b = m >> 13;
        if (b != bcur) { bcur = b;
#pragma unroll
            for (int j = 0; j < 4; ++j) { const int c0 = 8 * F.lane + 512 * (j >> 1) + 4 * (j & 1); nwv[j] = *(const f32x4*)(F.norm_w + c0);
#pragma unroll
                for (int k = 0; k < 4; ++k) { const int cidx = c0 + k;
                    shv[j][k] = __hip_atomic_load(F.MOD + b * 3072 + cidx, __ATOMIC_RELAXED, __HIP_MEMORY_SCOPE_AGENT) + F.b_ada[cidx];
                    scv[j][k] = __hip_atomic_load(F.MOD + b * 3072 + 1024 + cidx, __ATOMIC_RELAXED, __HIP_MEMORY_SCOPE_AGENT) + F.b_ada[1024 + cidx] + 1.0f; } } }
        const GAS f32x4* xr = (const GAS f32x4*)(F.x + (size_t)m * D) + 2 * F.lane;
        f32x4 v[4][4]; float sq[4];
#pragma unroll
        for (int r = 0; r < 4; ++r)
#pragma unroll
            for (int j = 0; j < 4; ++j) v[r][j] = __builtin_nontemporal_load(xr + 256 * r + 128 * (j >> 1) + (j & 1));
#pragma unroll
        for (int r = 0; r < 4; ++r) { sq[r] = 0.f;
#pragma unroll
            for (int j = 0; j < 4; ++j) sq[r] += (v[r][j].x * v[r][j].x + v[r][j].y * v[r][j].y) + (v[r][j].z * v[r][j].z + v[r][j].w * v[r][j].w); }
#pragma unroll
        for (int o = 1; o < 64; o <<= 1) {
#pragma unroll
            for (int r = 0; r < 4; ++r) sq[r] += __shfl_xor(sq[r], o); }
        const __amdgpu_buffer_rsrc_t xn_rsrc = __builtin_amdgcn_make_buffer_rsrc((void*)F.XN, (short)0, M * D * 2, 0x00020000);
        const unsigned xoff = (unsigned)m * D * 2u + 16u * F.lane;
#pragma unroll
        for (int r = 0; r < 4; ++r) { const float rs = 1.f / sqrtf(sq[r] * (1.f / D) + EPS);
#pragma unroll
            for (int jj = 0; jj < 2; ++jj) { const f32x4 h0 = v[r][2 * jj] * rs * nwv[2 * jj] * scv[2 * jj] + shv[2 * jj], h1 = v[r][2 * jj + 1] * rs * nwv[2 * jj + 1] * scv[2 * jj + 1] + shv[2 * jj + 1];
                v4u w; w.x = pk2(h0.x, h0.y); w.y = pk2(h0.z, h0.w); w.z = pk2(h1.x, h1.y); w.w = pk2(h1.z, h1.w);
                __builtin_amdgcn_raw_buffer_store_b128(w, xn_rsrc, xoff + (unsigned)(128 * r + 64 * jj) * 16u, 0,   16); } }
    }
}

__device__ __forceinline__ void p5_scan(Frame& F) {
    const int gtid = F.vcu * 512 + F.tid, NT = F.G * 512;
    for (int e = gtid; e < BATCH * SH * 8192 / 2; e += NT) {
        const int bh = e >> 12, pn = (e & 4095) * 2, b = bh >> 5, h = bh & 31;
        float r0 = 0.f, r1 = 0.f;
        for (int c = 0; c < NCH; ++c) {
            const int u = (b * NCH + c) * SH + h;
            GAS unsigned* sp = (GAS unsigned*)(F.ST + (size_t)u * 8192 + pn);
            const unsigned w = *sp; const float dec = F.CDEC[u];
            *sp = pk2(r0, r1);
            r0 = r0 * dec + blo(w); r1 = r1 * dec + bhi(w);
        }
    }
}


typedef float f32x16 __attribute__((ext_vector_type(16)));
typedef short s16x4 __attribute__((ext_vector_type(4)));
typedef short v4i16_t __attribute__((ext_vector_type(4)));
typedef unsigned v2u __attribute__((ext_vector_type(2)));
typedef float f32x2_t __attribute__((ext_vector_type(2))); typedef __bf16 bf16x2_t __attribute__((ext_vector_type(2)));
#define MFMA32(a, b, c) __builtin_amdgcn_mfma_f32_32x32x16_bf16((a), (b), (c), 0, 0, 0)
__device__ __forceinline__ unsigned cvtpk(float lo, float hi) { f32x2_t v = {lo, hi}; bf16x2_t b = __builtin_convertvector(v, bf16x2_t); return __builtin_bit_cast(unsigned, b); }
__device__ __forceinline__ s16x4 trr(LAS const unsigned char* p) { return __builtin_bit_cast(s16x4, __builtin_amdgcn_ds_read_tr16_b64_v4i16((LAS v4i16_t*)p)); }
__device__ __forceinline__ bf16x8 cat4(s16x4 lo, s16x4 hi) { return __builtin_shufflevector(lo, hi, 0, 1, 2, 3, 4, 5, 6, 7); }
__device__ __forceinline__ int crow(int reg, int h) { return (reg & 3) + 8 * (reg >> 2) + 4 * h; }
__device__ __forceinline__ bf16x8 pack_step(const f32x16& x, int s) {
    v4u p; p.x = cvtpk(x[8 * s], x[8 * s + 1]); p.y = cvtpk(x[8 * s + 2], x[8 * s + 3]); p.z = cvtpk(x[8 * s + 4], x[8 * s + 5]); p.w = cvtpk(x[8 * s + 6], x[8 * s + 7]);
    return __builtin_bit_cast(bf16x8, p);
}
__device__ __forceinline__ void unpack8(const v4u w, float* f) { f[0] = blo(w.x); f[1] = bhi(w.x); f[2] = blo(w.y); f[3] = bhi(w.y); f[4] = blo(w.z); f[5] = bhi(w.z); f[6] = blo(w.w); f[7] = bhi(w.w); }

__device__ __forceinline__ void p3_attn(Frame& F) {
    constexpr int KP = 144, VP = 192;
    constexpr float L2E = 1.4426950408889634f;
    LAS unsigned char* Kn = F.lds + RING_OFF;
    LAS unsigned char* Vs = F.lds + RING_OFF + 256 * KP;
    LAS float* tab = (LAS float*)(F.lds + SMALL_OFF);
    LAS unsigned char* Tw = F.lds + RING_OFF + 256 * KP + 256 * VP + F.wave * 4096;
    const int lane = F.lane, r32 = lane & 31, hh = lane >> 5, w = F.wave, g = w >> 1, qh = w & 1;
    const int blk = (lane >> 4) & 1, q4 = (lane & 15) >> 2, p4 = lane & 3;
    if ((F.G & 3) == 0) {
        const int hk0 = F.vcu & 3;
        for (int i = F.tid; i < 4 * 192; i += 512) { const int gg = i / 192, dist = i % 192 - 32;
            tab[i] = (dist >= 0 && dist < 128) ? F.rel_bias[t5_bucket(dist) * NHEAD + hk0 * 4 + gg] * L2E : -INFINITY; }
    }
    v4u qnext[4];
    if (F.vcu < BATCH * (SEQ / 128) * NKV) { const int u0 = F.vcu; const bf16* qg = F.Q + ((size_t)(u0 >> 8) * SEQ + (size_t)((u0 >> 2) & 63) * 128 + 64 * qh + (lane >> 3)) * D + ((u0 & 3) * 4 + g) * HD + (lane & 7) * 8;
#pragma unroll
        for (int i = 0; i < 4; ++i) qnext[i] = *(const GAS v4u*)(qg + (size_t)(8 * i) * D); }
    for (int u = F.vcu; u < BATCH * (SEQ / 128) * NKV; u += F.G) {
        const int hk = u & 3, nb = (u >> 2) & 63, b = u >> 8;
        const size_t tok0 = (size_t)b * SEQ + (size_t)nb * 128;
        if ((F.G & 3) != 0) { for (int i = F.tid; i < 4 * 192; i += 512) { const int gg = i / 192, dist = i % 192 - 32;
            tab[i] = (dist >= 0 && dist < 128) ? F.rel_bias[t5_bucket(dist) * NHEAD + hk * 4 + gg] * L2E : -INFINITY; } }
        const int head = hk * 4 + g;
        {
            const int key = F.tid >> 1, half = F.tid & 1;
            const bool valid = (nb > 0) || (key >= 128);
            const size_t krow = valid ? (tok0 + key - 128) : tok0;
            const bf16* kp = F.KB + krow * 256 + hk * HD + half * 32;
            const bf16* vp = F.VB + krow * 256 + hk * HD + half * 32;
            v4u kw[4], vw[4];
#pragma unroll
            for (int i = 0; i < 4; ++i) { kw[i] = *(const GAS v4u*)(kp + 8 * i); vw[i] = *(const GAS v4u*)(vp + 8 * i); }
            if (!valid) {
#pragma unroll
                for (int i = 0; i < 4; ++i) { kw[i] = (v4u){0u, 0u, 0u, 0u}; vw[i] = (v4u){0u, 0u, 0u, 0u}; } }
            float kf[32]; float ss = 0.f;
#pragma unroll
            for (int i = 0; i < 4; ++i) unpack8(kw[i], kf + 8 * i);
#pragma unroll
            for (int i = 0; i < 32; ++i) ss += kf[i] * kf[i];
            ss += __shfl_xor(ss, 1);
            const float rs = 1.f / sqrtf(ss * (1.f / 64.f) + EPS);
#pragma unroll
            for (int i = 0; i < 4; ++i) { const f32x4 w0 = *(const f32x4*)(F.k_norm_w + half * 32 + 8 * i), w1 = *(const f32x4*)(F.k_norm_w + half * 32 + 8 * i + 4);
                v4u o; o.x = cvtpk(kf[8 * i] * rs * w0[0], kf[8 * i + 1] * rs * w0[1]); o.y = cvtpk(kf[8 * i + 2] * rs * w0[2], kf[8 * i + 3] * rs * w0[3]);
                o.z = cvtpk(kf[8 * i + 4] * rs * w1[0], kf[8 * i + 5] * rs * w1[1]); o.w = cvtpk(kf[8 * i + 6] * rs * w1[2], kf[8 * i + 7] * rs * w1[3]);
                *(LAS v4u*)(Kn + key * KP + half * 64 + 16 * i) = o;
                *(LAS v4u*)(Vs + key * VP + half * 64 + 16 * i) = vw[i]; }
        }
        __syncthreads();
        const float sinkl = F.sinks[head] * L2E;
        const bool first = (nb == 0);
#pragma unroll 1
        for (int sb = 0; sb < 2; ++sb) {
            const int qi0 = 64 * qh + 32 * sb, kt0 = qi0 >> 5;
            bf16x8 qf[4];
            {
#pragma unroll
                for (int i = 0; i < 4; ++i) { const int r = 8 * i + (lane >> 3); *(LAS v4u*)(Tw + r * 128 + (((lane & 7) ^ ((r >> 1) & 7)) << 4)) = qnext[i]; }
                {
                    const int un = sb == 0 ? u : u + F.G;
                    if (un < BATCH * (SEQ / 128) * NKV) { const bf16* qg = F.Q + ((size_t)(un >> 8) * SEQ + (size_t)((un >> 2) & 63) * 128 + 64 * qh + (sb == 0 ? 32 : 0) + (lane >> 3)) * D + ((un & 3) * 4 + g) * HD + (lane & 7) * 8;
#pragma unroll
                        for (int i = 0; i < 4; ++i) qnext[i] = *(const GAS v4u*)(qg + (size_t)(8 * i) * D); }
                }
                v4u qr[4]; float qv[32]; float ss = 0.f;
#pragma unroll
                for (int ks = 0; ks < 4; ++ks) { qr[ks] = *(const LAS v4u*)(Tw + r32 * 128 + (((2 * ks + hh) ^ ((r32 >> 1) & 7)) << 4)); unpack8(qr[ks], qv + 8 * ks); }
#pragma unroll
                for (int i = 0; i < 32; ++i) ss += qv[i] * qv[i];
                ss += __shfl_xor(ss, 32);
                const float qs = 0.125f * L2E / sqrtf(ss * (1.f / 64.f) + EPS);
#pragma unroll
                for (int ks = 0; ks < 4; ++ks) { const f32x4 w0 = *(const f32x4*)(F.q_norm_w + 16 * ks + 8 * hh), w1 = *(const f32x4*)(F.q_norm_w + 16 * ks + 8 * hh + 4);
                    v4u o; o.x = cvtpk(qv[8 * ks] * qs * w0[0], qv[8 * ks + 1] * qs * w0[1]); o.y = cvtpk(qv[8 * ks + 2] * qs * w0[2], qv[8 * ks + 3] * qs * w0[3]);
                    o.z = cvtpk(qv[8 * ks + 4] * qs * w1[0], qv[8 * ks + 5] * qs * w1[1]); o.w = cvtpk(qv[8 * ks + 6] * qs * w1[2], qv[8 * ks + 7] * qs * w1[3]);
                    qf[ks] = __builtin_bit_cast(bf16x8, o); }
            }
            v4u zr4[4];
#pragma unroll
            for (int i = 0; i < 4; ++i) zr4[i] = *(const GAS v4u*)(F.ZA + (tok0 + qi0 + (lane >> 3) + 8 * i) * D + head * HD + (lane & 7) * 8);
            f32x16 X[5];
#pragma unroll
            for (int t = 0; t < 5; ++t) {
#pragma unroll
                for (int i = 0; i < 16; ++i) X[t][i] = tab[g * 192 + r32 + 160 - 32 * t - crow(i, hh)];
                const LAS unsigned char* kb = Kn + (32 * (kt0 + t) + r32) * KP + 16 * hh;
#pragma unroll
                for (int ks = 0; ks < 4; ++ks) { const bf16x8 a = *(const LAS bf16x8*)(kb + 32 * ks); X[t] = MFMA32(a, qf[ks], X[t]); }
            }
            if (first) {
#pragma unroll
                for (int t = 0; t < 5; ++t) if (kt0 + t < 4) {
#pragma unroll
                    for (int i = 0; i < 16; ++i) X[t][i] = -INFINITY; }
            }
            float mx = sinkl;
#pragma unroll
            for (int t = 0; t < 5; ++t)
#pragma unroll
                for (int i = 0; i < 16; ++i) mx = fmaxf(mx, X[t][i]);
            mx = fmaxf(mx, __shfl_xor(mx, 32));
            float sum = 0.f;
#pragma unroll
            for (int t = 0; t < 5; ++t)
#pragma unroll
                for (int i = 0; i < 16; ++i) { const float p = __builtin_amdgcn_exp2f(X[t][i] - mx); X[t][i] = p; sum += p; }
            sum += __shfl_xor(sum, 32);
            sum += __builtin_amdgcn_exp2f(sinkl - mx);
            f32x16 O[2];
#pragma unroll
            for (int i = 0; i < 16; ++i) { O[0][i] = 0.f; O[1][i] = 0.f; }
#pragma unroll
            for (int t = 0; t < 5; ++t)
#pragma unroll
                for (int s = 0; s < 2; ++s) { const bf16x8 pk = pack_step(X[t], s);
                    const LAS unsigned char* vb = Vs + (32 * (kt0 + t) + 16 * s + 4 * hh + q4) * VP + 32 * blk + 8 * p4;
#pragma unroll
                    for (int dt = 0; dt < 2; ++dt) { const bf16x8 a = cat4(trr(vb + 64 * dt), trr(vb + 8 * VP + 64 * dt)); O[dt] = MFMA32(a, pk, O[dt]); } }
            const float inv = 1.f / sum;
            {
#pragma unroll
                for (int i = 0; i < 4; ++i) { const int r = 8 * i + (lane >> 3); *(LAS v4u*)(Tw + r * 128 + (((lane & 7) ^ ((r >> 1) & 7)) << 4)) = zr4[i]; }
                LAS unsigned char* tr = Tw + r32 * 128 + 8 * hh; const int sw = (r32 >> 1) & 7;
#pragma unroll
                for (int dt = 0; dt < 2; ++dt)
#pragma unroll
                    for (int qd = 0; qd < 4; ++qd) { LAS v2u* pz = (LAS v2u*)(tr + (((4 * dt + qd) ^ sw) << 4)); const v2u z = *pz; v2u o;
                        o.x = cvtpk(O[dt][4 * qd] * inv * blo(z.x), O[dt][4 * qd + 1] * inv * bhi(z.x)); o.y = cvtpk(O[dt][4 * qd + 2] * inv * blo(z.y), O[dt][4 * qd + 3] * inv * bhi(z.y));
                        *pz = o; }
                bf16* og = F.Q + (tok0 + qi0 + (lane >> 3)) * D + head * HD + (lane & 7) * 8;
#pragma unroll
                for (int i = 0; i < 4; ++i) { const int r = 8 * i + (lane >> 3); const v4u v = *(const LAS v4u*)(Tw + r * 128 + (((lane & 7) ^ ((r >> 1) & 7)) << 4)); *(GAS v4u*)(og + (size_t)(8 * i) * D) = v; }
            }
        }
        __syncthreads();
    }
}

__device__ __forceinline__ void conv8_load(const bf16* XBC, size_t rowb, int t, int gc, v4u (&raw)[7], const bf16* pre, bool prev_ok) {
#pragma unroll
    for (int i = 0; i < 7; ++i) { const int tt = t - 3 + i;
        raw[i] = (v4u){0u, 0u, 0u, 0u};
        if (i < 3) { if (prev_ok) raw[i] = *(const GAS v4u*)(pre ? pre + i * 2048 : XBC + (rowb + tt) * XBCW + gc); }
        else raw[i] = *(const GAS v4u*)(XBC + (rowb + tt) * XBCW + gc); }
}
__device__ __forceinline__ void conv8_apply(const float* cw, const float* cb, int gc, const v4u (&raw)[7], float (&o)[4][8]) {
    float w[4][8];
#pragma unroll
    for (int j = 0; j < 4; ++j) { const f32x4 a = *(const f32x4*)(cw + j * XBCW + gc), c = *(const f32x4*)(cw + j * XBCW + gc + 4);
        w[j][0] = a[0]; w[j][1] = a[1]; w[j][2] = a[2]; w[j][3] = a[3]; w[j][4] = c[0]; w[j][5] = c[1]; w[j][6] = c[2]; w[j][7] = c[3]; }
    { const f32x4 a = *(const f32x4*)(cb + gc), c = *(const f32x4*)(cb + gc + 4);
#pragma unroll
      for (int r = 0; r < 4; ++r) { o[r][0] = a[0]; o[r][1] = a[1]; o[r][2] = a[2]; o[r][3] = a[3]; o[r][4] = c[0]; o[r][5] = c[1]; o[r][6] = c[2]; o[r][7] = c[3]; } }
#pragma unroll
    for (int i = 0; i < 7; ++i) { float x[8]; unpack8(raw[i], x);
#pragma unroll
        for (int r = 0; r < 4; ++r) { const int j = i - r;
            if (j >= 0 && j < 4) {
#pragma unroll
                for (int k = 0; k < 8; ++k) o[r][k] += w[j][k] * x[k]; } } }
#pragma unroll
    for (int r = 0; r < 4; ++r)
#pragma unroll
        for (int k = 0; k < 8; ++k) o[r][k] = o[r][k] * __builtin_amdgcn_rcpf(1.f + __builtin_amdgcn_exp2f(-1.4426950408889634f * o[r][k]));
}
__device__ __forceinline__ v4u pack8(const float* f, float s) { v4u o; o.x = cvtpk(f[0] * s, f[1] * s); o.y = cvtpk(f[2] * s, f[3] * s); o.z = cvtpk(f[4] * s, f[5] * s); o.w = cvtpk(f[6] * s, f[7] * s); return o; }

__device__ __forceinline__ void chunk_cumsum(const float* DT, size_t row0, int hd, float a, int lane, float& d0, float& d1, float& ac0, float& ac1, float& aend) {
    { const f32x2_t dd = *(const GAS f32x2_t*)(DT + ((row0 >> 7) * 32 + hd) * 128 + 2 * lane); d0 = dd[0]; d1 = dd[1]; }
    const float v1 = d1 * a; float s = d0 * a + v1;
#pragma unroll
    for (int o = 1; o < 64; o <<= 1) { const float t = __shfl_up(s, o); if (lane >= o) s += t; }
    aend = __shfl(s, 63); ac1 = s; ac0 = s - v1;
}

__device__ __forceinline__ void p4_states(Frame& F) {
    constexpr int XP = 576, BP = 320;
    LAS unsigned char* Xw = F.lds + RING_OFF;
    LAS unsigned char* Bs = F.lds + RING_OFF + 128 * XP;
    LAS float* sW = (LAS float*)(F.lds + SMALL_OFF);
    const int lane = F.lane, r32 = lane & 31, hh = lane >> 5, w = F.wave, hl = w >> 1, nh = w & 1;
    const int blk = (lane >> 4) & 1, q4 = (lane & 15) >> 2, p4 = lane & 3;
    v4u raw[3][7];
#define P4_ISSUE(un) do { const int hq_ = (un) & 1, g_ = ((un) >> 1) & 3, c_ = ((un) >> 3) & 63, b_ = (un) >> 9; const size_t rowb_ = (size_t)b_ * SEQ; \
        _Pragma("unroll") for (int k_ = 0; k_ < 3; ++k_) { const int it_ = F.tid + 512 * k_, ch_ = it_ % 48, rg_ = it_ / 48, l0_ = rg_ * 4; \
            if (ch_ < 32) { const int gc_ = (g_ * 8 + hq_ * 4) * 64 + ch_ * 8; const bool first_ = (rg_ == 0); \
                conv8_load(F.XBC, rowb_, c_ * CH + l0_, gc_, raw[k_], first_ ? F.HALO + ((size_t)(b_ * NCH + c_ - 1) * 3) * 2048 + gc_ : nullptr, !first_ || c_ > 0); } \
            else { const int gc_ = SSMW + g_ * SN + (ch_ - 32) * 8; conv8_load(F.XBC, rowb_, c_ * CH + l0_, gc_, raw[k_], nullptr, c_ * CH + l0_ > 0); } } } while (0)
    if (F.vcu < BATCH * NCH * SG * 2) P4_ISSUE(F.vcu);
    for (int u = F.vcu; u < BATCH * NCH * SG * 2; u += F.G) {
        const int hq = u & 1, g = (u >> 1) & 3, c = (u >> 3) & 63, b = u >> 9;
        const int t0 = c * CH; const size_t rowb = (size_t)b * SEQ, row0 = rowb + t0;
        if (w < 4) { const int hd = g * 8 + hq * 4 + w; float d0, d1, ac0, ac1, aend; int ln = lane; asm volatile("" : "+v"(ln));
            chunk_cumsum(F.DT, row0, hd, -__expf(F.a_log[hd]), ln, d0, d1, ac0, ac1, aend);
            sW[w * 128 + 2 * ln] = d0 * __expf(aend - ac0); sW[w * 128 + 2 * ln + 1] = d1 * __expf(aend - ac1);
            if (ln == 63) F.CDEC[(b * NCH + c) * SH + hd] = __expf(aend); }
#pragma unroll
        for (int itk = 0; itk < 3; ++itk) { const int it = F.tid + 512 * itk;
            const int ch = it % 48, rg = it / 48, l0 = rg * 4;
            float o[4][8];
            if (ch < 32) {
                conv8_apply(F.conv_w, F.conv_b, (g * 8 + hq * 4) * 64 + ch * 8, raw[itk], o);
#pragma unroll
                for (int r = 0; r < 4; ++r) *(LAS v4u*)(Xw + (l0 + r) * XP + ch * 16) = pack8(o[r], 1.f);
            } else {
                conv8_apply(F.conv_w, F.conv_b, SSMW + g * SN + (ch - 32) * 8, raw[itk], o);
#pragma unroll
                for (int r = 0; r < 4; ++r) *(LAS v4u*)(Bs + (l0 + r) * BP + (ch - 32) * 16) = pack8(o[r], 1.f);
            }
        }
        __syncthreads();
        if (u + F.G < BATCH * NCH * SG * 2) P4_ISSUE(u + F.G);
        f32x16 acc[2][2];
#pragma unroll
        for (int i = 0; i < 16; ++i) { acc[0][0][i] = 0.f; acc[0][1][i] = 0.f; acc[1][0][i] = 0.f; acc[1][1][i] = 0.f; }
        const LAS unsigned char* ab = Bs + (8 * hh + q4) * BP + 128 * nh + 32 * blk + 8 * p4;
        const LAS unsigned char* bb = Xw + (8 * hh + q4) * XP + 128 * hl + 32 * blk + 8 * p4;
        bf16* xt = F.XBC + (row0 + (size_t)(hl * 32 + hh)) * XBCW + g * 512 + hq * 256 + r32 * 8;
#pragma unroll 2
        for (int ks = 0; ks < 8; ++ks) {
            bf16x8 A[2], B[2];
#pragma unroll
            for (int nt = 0; nt < 2; ++nt) A[nt] = cat4(trr(ab + 16 * ks * BP + 64 * nt), trr(ab + (16 * ks + 4) * BP + 64 * nt));
#pragma unroll
            for (int pt = 0; pt < 2; ++pt) B[pt] = cat4(trr(bb + 16 * ks * XP + 64 * pt), trr(bb + (16 * ks + 4) * XP + 64 * pt));
            {
                const f32x4 w0 = *(const LAS f32x4*)(sW + hl * 128 + 16 * ks + 8 * hh), w1 = *(const LAS f32x4*)(sW + hl * 128 + 16 * ks + 8 * hh + 4);
#pragma unroll
                for (int nt = 0; nt < 2; ++nt) { const v4u a = __builtin_bit_cast(v4u, A[nt]); v4u o;
                    o.x = cvtpk(blo(a.x) * w0[0], bhi(a.x) * w0[1]); o.y = cvtpk(blo(a.y) * w0[2], bhi(a.y) * w0[3]); o.z = cvtpk(blo(a.z) * w1[0], bhi(a.z) * w1[1]); o.w = cvtpk(blo(a.w) * w1[2], bhi(a.w) * w1[3]);
                    A[nt] = __builtin_bit_cast(bf16x8, o); }
            }
            if (nh == 0) {
#pragma unroll
                for (int pt = 0; pt < 2; ++pt) *(GAS v4u*)(xt + (size_t)((ks * 2 + pt) * 2) * XBCW) = __builtin_bit_cast(v4u, B[pt]);
            }
#pragma unroll
            for (int nt = 0; nt < 2; ++nt)
#pragma unroll
                for (int pt = 0; pt < 2; ++pt) acc[nt][pt] = MFMA32(A[nt], B[pt], acc[nt][pt]);
        }
        {
            const int hd = g * 8 + hq * 4 + hl;
            bf16* sp = F.ST + (size_t)((b * NCH + c) * SH + hd) * 8192;
#pragma unroll
            for (int nt = 0; nt < 2; ++nt)
#pragma unroll
                for (int pt = 0; pt < 2; ++pt)
#pragma unroll
                    for (int qd = 0; qd < 4; ++qd) { v2u o; o.x = cvtpk(acc[nt][pt][4 * qd], acc[nt][pt][4 * qd + 1]); o.y = cvtpk(acc[nt][pt][4 * qd + 2], acc[nt][pt][4 * qd + 3]);
                        *(GAS v2u*)(sp + (((2 * (2 * nh + nt) + (qd >> 1)) * 2 + pt) * 64 + (qd & 1) * 32 + r32) * 8 + 4 * hh) = o; }
        }
        __syncthreads();
    }
#undef P4_ISSUE
}

__device__ __forceinline__ void p6_scan(Frame& F) {
    constexpr int CP = 272;
    LAS unsigned char* Cs = F.lds + RING_OFF;
    LAS unsigned char* Bs = F.lds + RING_OFF + 128 * CP;
    LAS float* sDT = (LAS float*)(F.lds + SMALL_OFF);
    LAS float* sAC = sDT + 1024;
    LAS float* ssq = sDT + 2048;
    LAS float* sES = ssq;
    const int lane = F.lane, r32 = lane & 31, hh = lane >> 5, w = F.wave;
    for (int u = F.vcu; u < BATCH * NCH * SG; u += F.G) {
        const int g = u & 3, c = (u >> 2) & 63, b = u >> 8;
        const int t0 = c * CH; const size_t rowb = (size_t)b * SEQ, row0 = rowb + t0;
        const int hd = g * 8 + w;
        { float d0, d1, ac0, ac1, aend; int ln = lane; asm volatile("" : "+v"(ln));
          chunk_cumsum(F.DT, row0, hd, -__expf(F.a_log[hd]), ln, d0, d1, ac0, ac1, aend);
          sDT[w * 128 + 2 * ln] = d0; sDT[w * 128 + 2 * ln + 1] = d1; sAC[w * 128 + 2 * ln] = ac0; sAC[w * 128 + 2 * ln + 1] = ac1;
          const float et = __shfl(ac1, 16 * (ln >> 4) + 15);
          sES[w * 128 + 2 * ln] = d0 * __expf(et - ac0); sES[w * 128 + 2 * ln + 1] = d1 * __expf(et - ac1); }
        {
            v4u raw[2][7];
#pragma unroll
            for (int it2 = 0; it2 < 2; ++it2) { const int it = F.tid + 512 * it2, ch = it & 31, l0 = (it >> 5) * 4;
                conv8_load(F.XBC, rowb, t0 + l0, SSMW + (ch < 16 ? 0 : SG * SN) + g * SN + (ch & 15) * 8, raw[it2], nullptr, t0 + l0 > 0); }
#pragma unroll
            for (int it2 = 0; it2 < 2; ++it2) { const int it = F.tid + 512 * it2, ch = it & 31, l0 = (it >> 5) * 4;
                float o[4][8];
                conv8_apply(F.conv_w, F.conv_b, SSMW + (ch < 16 ? 0 : SG * SN) + g * SN + (ch & 15) * 8, raw[it2], o);
                LAS unsigned char* dst = (ch < 16 ? Bs : Cs) + l0 * CP + (ch & 15) * 16;
#pragma unroll
                for (int r = 0; r < 4; ++r) *(LAS v4u*)(dst + r * CP) = pack8(o[r], 1.f);
                asm volatile("" ::: "memory"); }
        }
        bf16x8 HA[8][2];
        { int ln2 = lane; asm volatile("" : "+v"(ln2));
          const bf16* hp = F.ST + (size_t)((b * NCH + c) * SH + hd) * 8192 + ln2 * 8;
#pragma unroll
          for (int ks = 0; ks < 8; ++ks)
#pragma unroll
              for (int pt = 0; pt < 2; ++pt) HA[ks][pt] = __builtin_bit_cast(bf16x8, *(const GAS v4u*)(hp + (ks * 2 + pt) * 512)); }
        __syncthreads();
        f32x16 yacc[4][2];
#pragma unroll
        for (int lt = 0; lt < 4; ++lt)
#pragma unroll
            for (int i = 0; i < 16; ++i) { yacc[lt][0][i] = 0.f; yacc[lt][1][i] = 0.f; }
        {
            const LAS unsigned char* cb = Cs + r32 * CP + 16 * hh;
#pragma unroll
            for (int ks = 0; ks < 8; ++ks) {
                bf16x8 Bf[4];
#pragma unroll
                for (int lt = 0; lt < 4; ++lt) Bf[lt] = *(const LAS bf16x8*)(cb + 32 * lt * CP + 32 * ks);
#pragma unroll
                for (int lt = 0; lt < 4; ++lt)
#pragma unroll
                    for (int pt = 0; pt < 2; ++pt) yacc[lt][pt] = MFMA32(HA[ks][pt], Bf[lt], yacc[lt][pt]);
                if (ks & 1) asm volatile("" ::: "memory");
            }
#pragma unroll
            for (int lt = 0; lt < 4; ++lt) { const float e = __expf(sAC[w * 128 + 32 * lt + r32]);
#pragma unroll
                for (int i = 0; i < 16; ++i) { yacc[lt][0][i] *= e; yacc[lt][1][i] *= e; } }
        }
        const float dsk = F.d_skip[hd];
        const bf16* xt = F.XBC + (row0 + (size_t)((w & 3) * 32)) * XBCW + g * 512 + (w >> 2) * 256 + r32 * 8 + 4 * hh;
#pragma unroll 1
        for (int st = 0; st < 4; ++st) {
            v2u xr[2][2][2];
#pragma unroll
            for (int s = 0; s < 2; ++s)
#pragma unroll
                for (int pt = 0; pt < 2; ++pt)
#pragma unroll
                    for (int hf = 0; hf < 2; ++hf) xr[s][pt][hf] = *(const GAS v2u*)(xt + (size_t)(((2 * st + s) * 2 + pt) * 2 + hf) * XBCW);
            const LAS unsigned char* ab = Bs + (32 * st + r32) * CP + 16 * hh;
#pragma unroll
            for (int lt = 0; lt < 4; ++lt) {
                if (lt >= st) {
                    f32x16 X;
#pragma unroll
                    for (int i = 0; i < 16; ++i) X[i] = 0.f;
                    const LAS unsigned char* cb = Cs + (32 * lt + r32) * CP + 16 * hh; const float acl_lt = sAC[w * 128 + 32 * lt + r32];
#pragma unroll 2
                    for (int ks = 0; ks < 8; ++ks) X = MFMA32(*(const LAS bf16x8*)(ab + 32 * ks), *(const LAS bf16x8*)(cb + 32 * ks), X);
                    if (lt == st) {
#pragma unroll
                        for (int qd = 0; qd < 4; ++qd) { const int sl0 = 8 * qd + 4 * hh;
                            const f32x4 av = *(const LAS f32x4*)(sAC + w * 128 + 32 * st + sl0), dv = *(const LAS f32x4*)(sDT + w * 128 + 32 * st + sl0);
#pragma unroll
                            for (int k = 0; k < 4; ++k) { float f = __expf(acl_lt - av[k]) * dv[k];
                                if (sl0 + k > r32) f = 0.f;
                                float v = X[4 * qd + k] * f;
                                if (sl0 + k == r32) v += dsk;
                                X[4 * qd + k] = v; }
                            asm volatile("" ::: "memory"); }
                    } else {
                        const float cl = __expf(acl_lt - sAC[w * 128 + 32 * st + 31]);
#pragma unroll
                        for (int qd = 0; qd < 4; ++qd) { const f32x4 ev = *(const LAS f32x4*)(sES + w * 128 + 32 * st + 8 * qd + 4 * hh);
#pragma unroll
                            for (int k = 0; k < 4; ++k) X[4 * qd + k] *= cl * ev[k]; }
                    }
#pragma unroll
                    for (int s = 0; s < 2; ++s) { const bf16x8 xp = pack_step(X, s);
#pragma unroll
                        for (int pt = 0; pt < 2; ++pt) { const v4u xa = (v4u){xr[s][pt][0].x, xr[s][pt][0].y, xr[s][pt][1].x, xr[s][pt][1].y};
                            yacc[lt][pt] = MFMA32(__builtin_bit_cast(bf16x8, xa), xp, yacc[lt][pt]); } }
                }
            }
        }
        LAS unsigned char* Yw = F.lds + RING_OFF + w * 16384;
        {
            int ln4 = lane; asm volatile("" : "+v"(ln4));
            const bf16* zg = F.ZM + (size_t)(hd >> 4) * M * 1024 + (row0 + (ln4 >> 3)) * 1024 + (hd & 15) * 64 + (ln4 & 7) * 8;
            v4u zr[8];
#pragma unroll
            for (int i = 0; i < 8; ++i) zr[i] = *(const GAS v4u*)(zg + (size_t)(8 * i) * 1024);
            __syncthreads();
#pragma unroll 1
            for (int hb = 0; hb < 2; ++hb) {
#pragma unroll
                for (int i = 0; i < 8; ++i) { const int t = 8 * (8 * hb + i) + (lane >> 3); *(LAS v4u*)(Yw + t * 128 + (((lane & 7) ^ ((t >> 1) & 7)) << 4)) = zr[i]; }
                if (hb == 0) {
#pragma unroll
                    for (int i = 0; i < 8; ++i) zr[i] = *(const GAS v4u*)(zg + (size_t)(8 * (8 + i)) * 1024); }
                asm volatile("" ::: "memory"); }
        }
        float ss[4];
#pragma unroll
        for (int lt = 0; lt < 4; ++lt) { ss[lt] = 0.f; const int t = 32 * lt + r32; const LAS unsigned char* yr = Yw + t * 128 + 8 * hh; const int sw = (t >> 1) & 7;
#pragma unroll
            for (int pt = 0; pt < 2; ++pt)
#pragma unroll
                for (int qd = 0; qd < 4; ++qd) { const v2u z = *(const LAS v2u*)(yr + (((4 * pt + qd) ^ sw) << 4));
                    const float y0 = yacc[lt][pt][4 * qd] * blo(z.x), y1 = yacc[lt][pt][4 * qd + 1] * bhi(z.x), y2 = yacc[lt][pt][4 * qd + 2] * blo(z.y), y3 = yacc[lt][pt][4 * qd + 3] * bhi(z.y);
                    yacc[lt][pt][4 * qd] = y0; yacc[lt][pt][4 * qd + 1] = y1; yacc[lt][pt][4 * qd + 2] = y2; yacc[lt][pt][4 * qd + 3] = y3;
                    ss[lt] += (y0 * y0 + y1 * y1) + (y2 * y2 + y3 * y3); }
            ss[lt] += __shfl_xor(ss[lt], 32);
            if (hh == 0) ssq[w * 128 + t] = ss[lt];
            asm volatile("" ::: "memory"); }
        __syncthreads();
#pragma unroll
        for (int lt = 0; lt < 4; ++lt) { float tot = 0.f; const int t = 32 * lt + r32;
#pragma unroll
            for (int k = 0; k < 8; ++k) tot += ssq[k * 128 + t];
            const float rs = 1.f / sqrtf(tot * (1.f / 512.f) + EPS);
            LAS unsigned char* yr = Yw + t * 128 + 8 * hh; const int sw = (t >> 1) & 7; const float* nw = F.ssm_norm_w + hd * 64 + 4 * hh;
#pragma unroll
            for (int pt = 0; pt < 2; ++pt)
#pragma unroll
                for (int qd = 0; qd < 4; ++qd) { const f32x4 wv = *(const f32x4*)(nw + 32 * pt + 8 * qd); v2u o;
                    o.x = cvtpk(yacc[lt][pt][4 * qd] * rs * wv[0], yacc[lt][pt][4 * qd + 1] * rs * wv[1]); o.y = cvtpk(yacc[lt][pt][4 * qd + 2] * rs * wv[2], yacc[lt][pt][4 * qd + 3] * rs * wv[3]);
                    *(LAS v2u*)(yr + (((4 * pt + qd) ^ sw) << 4)) = o; }
            asm volatile("" ::: "memory"); }
        {
            int ln3 = lane; asm volatile("" : "+v"(ln3));
            bf16* zg = F.ZM + (size_t)(hd >> 4) * M * 1024 + (row0 + (ln3 >> 3)) * 1024 + (hd & 15) * 64 + (ln3 & 7) * 8;
#pragma unroll 4
            for (int i = 0; i < 16; ++i) { const int t = 8 * i + (lane >> 3); const v4u v = *(const LAS v4u*)(Yw + t * 128 + (((lane & 7) ^ ((t >> 1) & 7)) << 4)); *(GAS v4u*)(zg + (size_t)(8 * i) * 1024) = v; if ((i & 3) == 3) asm volatile("" ::: "memory"); }
        }
        __syncthreads();
    }
}

struct Args { const float* in[19]; float* out; unsigned char* ws; int ph_lo, ph_hi, li, pad; };
__global__ void __launch_bounds__(NWAVES * 64, 2) mk_fwd(Args args) {
    extern __shared__ __attribute__((aligned(16))) unsigned char lds[];
    Frame F;
    F.lds = (LAS unsigned char*)lds;
    F.MISC = (volatile LAS unsigned*)(F.lds + MISC_OFF);
    F.tid = threadIdx.x; F.lane = F.tid & 63; F.wave = __builtin_amdgcn_readfirstlane(F.tid >> 6);
    F.G = gridDim.x; { const int bx = blockIdx.x; F.vcu = (F.G % 8 == 0) ? (bx % 8) * (F.G / 8) + bx / 8 : bx; }
    unsigned char* ws = args.ws;
    F.ctl = (gu32*)(ws + WS_CTL);
    F.x = args.in[0]; F.c = args.in[1]; F.w_ada = args.in[2]; F.b_ada = args.in[3]; F.norm_w = args.in[4]; F.w_in = args.in[5]; F.q_norm_w = args.in[6]; F.k_norm_w = args.in[7];
    F.rel_bias = args.in[8]; F.sinks = args.in[9]; F.conv_w = args.in[10]; F.conv_b = args.in[11]; F.dt_bias = args.in[12]; F.a_log = args.in[13]; F.d_skip = args.in[14];
    F.ssm_norm_w = args.in[15]; F.w_attn = args.in[16]; F.w_ssm = args.in[17]; F.w_out = args.in[18]; F.out = args.out;
    F.WIN = (bf16*)(ws + WS_WIN); F.WA = (bf16*)(ws + WS_WA); F.WS = (bf16*)(ws + WS_WS); F.WO = (bf16*)(ws + WS_WO);
    F.XN = (bf16*)(ws + WS_XN); F.Q = (bf16*)(ws + WS_Q); F.ZM = (bf16*)(ws + WS_ZM); F.XBC = (bf16*)(ws + WS_XBC);
    F.HALO = (bf16*)(ws + WS_HALO); F.GA = (bf16*)(ws + WS_GA); F.GB = (bf16*)(ws + WS_GB); F.MG = (bf16*)(ws + WS_MG);
    F.KB = (bf16*)((unsigned char*)args.out + OUT_K); F.VB = (bf16*)((unsigned char*)args.out + OUT_V); F.ZA = (bf16*)((unsigned char*)args.out + OUT_ZA); F.ST = (bf16*)((unsigned char*)args.out + OUT_ST);
    F.MOD = (float*)(ws + WS_MISC); F.CDEC = (float*)(ws + WS_MISC + 32768); F.DT = (float*)(ws + WS_DT);
    for (int u = F.tid; u < (LDS_BYTES - LDSCTL_OFF) / 4; u += NWAVES * 64) ((LAS unsigned*)(F.lds + LDSCTL_OFF))[u] = 0u;
    __syncthreads();
    XcdBarrier bar; bar.bar = (unsigned*)(F.ctl + CW_BAR); bar.x = 0; bar.st = nullptr;
    if (N_LAUNCHES != PER_PHASE) bar = xcd_barrier_post((unsigned*)(F.ctl + CW_BAR), F.MISC + 8);
#define GRID_BAR() do { if (N_LAUNCHES != PER_PHASE) xcd_barrier(bar); } while (0)
    const int lo = args.ph_lo, hi = args.ph_hi;
#define IN(k) (lo <= (k) && (k) < hi)
#define BOTH(k) (IN(k) && IN((k) + 1))


#define PH0() do { if (IN(0)) { p0_prologue(F); } } while (0)
#define PH1() do { if (IN(1)) { p0_wait_mod(F); p1_norm(F); if (BOTH(1)) GRID_BAR(); } } while (0)
#define PH2() do { if (IN(2)) { \
        pg8::Gemm g{F.XN, F.WIN, M, N_MAIN, D}; pg8::StaticOrder S; S.init(M, N_MAIN, F.G, (int)blockIdx.x); \
        pg8::EpiInProj E{F.Q, F.KB, F.VB, F.ZA, F.ZM, F.XBC, F.GA, F.GB, F.DT, F.dt_bias, 0, F.HALO}; \
        pg8::gemm_phase<pg8::EpiInProj, pg8::StaticOrder, PG8_ALIGN, PG8_SP2>(F.lds + RING_OFF, g, S, E); \
        { const int nfull = (M / 256) * (N_MAIN / 256) % (int)F.G;     \
          if ((int)blockIdx.x >= nfull) p0_late(F, nfull); } \
        if (BOTH(2)) GRID_BAR(); } } while (0)
#define PH3() do { if (IN(3)) { p3_attn(F); if (BOTH(3)) GRID_BAR(); } } while (0)
#define PH4() do { if (IN(4)) { p4_states(F); if (BOTH(4)) GRID_BAR(); } } while (0)
#define PH5() do { if (IN(5)) { p5_scan(F); if (BOTH(5)) GRID_BAR(); } } while (0)
#define PH6() do { if (IN(6)) { p6_scan(F); if (BOTH(6)) GRID_BAR(); } } while (0)
#ifndef PAIR_BARRIER
#define PAIR_BARRIER 0
#endif
#define PH7() do { if (IN(7)) { \
        pg8::Gemm g{F.XN, F.WIN + (size_t)N_MAIN * D, M, N_GATE, D}; pg8::PairOrder S; S.base.init(M, D, F.G, (int)blockIdx.x); \
        pg8::EpiInProj E{F.Q, F.KB, F.VB, F.ZA, F.ZM, F.XBC, F.GA, F.GB, F.DT, F.dt_bias, 31, F.HALO}; \
        pg8::gemm_phase<pg8::EpiInProj, pg8::PairOrder, PG8_ALIGN, PG8_SP2>(F.lds + RING_OFF, g, S, E); \
        if (PAIR_BARRIER && BOTH(7)) GRID_BAR(); } } while (0)
#define PH8() do { if (IN(8)) { \
        { pg8::Gemm g{F.Q, F.WA, M, D, D}; pg8::StaticOrder S; S.init(M, D, F.G, (int)blockIdx.x); \
          pg8::EpiGate<0> E{F.GA, F.MG}; \
          pg8::gemm_phase<pg8::EpiGate<0>, pg8::StaticOrder, PG8_ALIGN, PG8_SP2>(F.lds + RING_OFF, g, S, E); } \
        { pg8::Gemm g{F.ZM, F.WS, M, D, D}; pg8::ChainOrder S; S.base.init(M, D, F.G, (int)blockIdx.x); S.ZM = F.ZM; S.WS = F.WS; \
          pg8::EpiGate<1> E{F.GB, F.MG}; \
          pg8::gemm_phase<pg8::EpiGate<1>, pg8::ChainOrder, PG8_ALIGN, PG8_SP2>(F.lds + RING_OFF, g, S, E); } \
        if (BOTH(8)) GRID_BAR(); } } while (0)
#define PH9(LAST) do { if (IN(9)) { \
        pg8::Gemm g{F.MG, F.WO, M, D, D}; pg8::StaticOrder S; S.init(M, D, F.G, (int)blockIdx.x); \
        pg8::EpiOut E{F.x, F.MOD + 2048, F.b_ada + 2048, F.out}; \
        pg8::gemm_phase<pg8::EpiOut, pg8::StaticOrder, PG8_ALIGN, PG8_SP2>(F.lds + RING_OFF, g, S, E); \
        if (!(LAST)) GRID_BAR(); } } while (0)
#ifndef REP
#define REP 0
#endif
#ifdef TPROBE
    unsigned long long tp0 = 0, tp1 = 0;
#define TP(k, X) do { if ((k) == TPROBE) tp0 = rt(); X; if ((k) == TPROBE) tp1 = rt(); } while (0)
#else
#define TP(k, X) do { X; } while (0)
#endif
    TP(0, PH0()); TP(1, PH1()); TP(2, PH2()); TP(3, PH3()); TP(4, PH4()); TP(5, PH5()); TP(6, PH6()); TP(7, PH7()); TP(8, PH8()); TP(9, PH9(true));
#ifdef TPROBE
    if (blockIdx.x == 0) { const unsigned long long need = (tp1 - tp0) * 8ull, s0 = rt(); while (rt() - s0 < need) __builtin_amdgcn_s_sleep(20); }
#endif
#undef IN
#undef BOTH
}

extern "C" void kernel_launch(void* const* d_in, const int* in_sizes, int n_in, void* d_out, int out_size, void* d_ws, size_t ws_size, hipStream_t stream) {
    static int grid = 0;
    if (grid == 0) {
        if (n_in != 19 || in_sizes[0] != M * D || out_size != M * D || ws_size < WS_END) { fprintf(stderr, "kernel_launch: unexpected shapes (n_in %d, in0 %d, out %d, ws %zu); nothing launched\n", n_in, n_in > 0 ? in_sizes[0] : -1, out_size, ws_size); grid = -1; return; }
        int dev = 0, cus = 0, per_cu = 0;
        if (hipGetDevice(&dev) != hipSuccess || hipDeviceGetAttribute(&cus, hipDeviceAttributeMultiprocessorCount, dev) != hipSuccess) { grid = -1; return; }
        if (hipFuncSetAttribute((const void*)mk_fwd, hipFuncAttributeMaxDynamicSharedMemorySize, LDS_BYTES) != hipSuccess) { fprintf(stderr, "kernel_launch: hipFuncSetAttribute failed\n"); grid = -1; return; }
        if (hipOccupancyMaxActiveBlocksPerMultiprocessor(&per_cu, (const void*)mk_fwd, NWAVES * 64, LDS_BYTES) != hipSuccess || per_cu < 1) { fprintf(stderr, "kernel_launch: occupancy query says %d blocks/CU\n", per_cu); }
        (void)hipGetLastError();
        grid = cus;
    }
    if (grid < 0) return;
    (void)hipMemsetAsync((char*)d_ws + WS_CTL, 0, CTL_ZERO_BYTES, stream);
    (void)hipMemsetAsync((char*)d_ws + WS_MISC, 0, 2 * 3072 * sizeof(float), stream);
    Args a{};
    for (int i = 0; i < 19; ++i) a.in[i] = (const float*)d_in[i];
    a.out = (float*)d_out; a.ws = (unsigned char*)d_ws;
    for (int li = 0; li < N_LAUNCHES; ++li) {
        a.ph_lo = (N_LAUNCHES == PER_PHASE) ? li : 0; a.ph_hi = (N_LAUNCHES == PER_PHASE) ? li + 1 : PER_PHASE; a.li = li;
        hipLaunchKernelGGL(mk_fwd, dim3(grid), dim3(NWAVES * 64), LDS_BYTES, stream, a);
    }
}
```
